# Optimizing an MI355X kernel written in HIP

```python
import math
import jax
import jax.numpy as jnp
from jax import lax
import numpy as np

D_MODEL = 1024
BATCH = 16
SEQ = 2048
DEPTH = 4

N_EVEN = (DEPTH + 1) // 2
N_ODD = DEPTH // 2

GLA_HEADS = 4
GLA_DV = D_MODEL // (2 * GLA_HEADS)
GLA_DK = GLA_DV // 2
GLA_RANK = 16
GLA_GATE_NORM = 16.0
GLA_CHUNK = 16

HGRN_HEADS = 4
HGRN_DV = D_MODEL // (2 * HGRN_HEADS)
HGRN_DK = HGRN_DV // 2
HGRN_CHUNK = 16
HGRN_MIN_F = 1e-20

RET_HEADS = 4
RET_DK = D_MODEL // (2 * RET_HEADS)
RET_DV = (3 * D_MODEL) // (4 * RET_HEADS)
RET_CHUNK = 64
ROPE_BASE = 10000.0

S5_WIDTH = D_MODEL // 4
S5_GROUP_CH = 16
S5_GROUPS = S5_WIDTH // S5_GROUP_CH
S5_STATE = 64

FFN_DIM = ((8 * D_MODEL // 3 + 255) // 256) * 256
CONV_WIDTH = 3
EPS = 1e-6

EVEN_COLS = (GLA_HEADS * GLA_DK, GLA_HEADS * GLA_DK, GLA_HEADS * GLA_DV, GLA_HEADS * GLA_DV, GLA_RANK, GLA_RANK,
             HGRN_HEADS * HGRN_DK, HGRN_HEADS * HGRN_DK, HGRN_HEADS * HGRN_DK, HGRN_HEADS * HGRN_DV, HGRN_HEADS * HGRN_DV)
ODD_COLS = (RET_HEADS * RET_DK, RET_HEADS * RET_DK, RET_HEADS * RET_DV, RET_HEADS * RET_DV, S5_WIDTH)
EVEN_IN = sum(EVEN_COLS)
ODD_IN = sum(ODD_COLS)
EVEN_MIX = GLA_HEADS * GLA_DV + HGRN_HEADS * HGRN_DV
ODD_MIX = RET_HEADS * RET_DV + S5_WIDTH

kernel_name = 'bidir_hybrid_gla_hgrn2_retnet_s5_convffn'

F32 = jnp.float32


def _split(p, sizes):
    return jnp.split(p, np.cumsum(sizes)[:-1].tolist(), axis=-1)


def rmsnorm(x, g):
    xf = x.astype(F32)
    y = xf * lax.rsqrt(jnp.mean(xf * xf, axis=-1, keepdims=True) + EPS)
    return (y * g.astype(F32)).astype(x.dtype)


def to_heads(t, h):
    b, s, _ = t.shape
    return t.reshape(b, s, h, -1).transpose(0, 2, 1, 3).astype(F32)


def from_heads(t):
    return t.transpose(0, 2, 1, 3)


def head_rmsnorm(o, g):
    b, s, h, d = o.shape
    y = o * lax.rsqrt(jnp.mean(o * o, axis=-1, keepdims=True) + EPS)
    return (y * g.astype(F32).reshape(h, d)).reshape(b, s, h * d)


def head_groupnorm(o, g):
    b, s, h, d = o.shape
    mu = jnp.mean(o, axis=-1, keepdims=True)
    c = o - mu
    y = c * lax.rsqrt(jnp.mean(c * c, axis=-1, keepdims=True) + EPS)
    return (y * g.astype(F32).reshape(h, d)).reshape(b, s, h * d)


def chunk_gated_scan(q, k, v, log_a, chunk):
    b, h, s, dk = q.shape
    dv = v.shape[-1]
    dg = log_a.shape[-1]
    n = s // chunk
    q, k, v, log_a = (t.reshape(b, h, n, chunk, t.shape[-1]) for t in (q, k, v, log_a))
    cum = jnp.cumsum(log_a, axis=3)
    last = cum[:, :, :, -1:, :]
    pos = jnp.arange(chunk)
    lower = (pos[:, None] >= pos[None, :])[:, :, None]
    rel = cum[:, :, :, :, None, :] - cum[:, :, :, None, :, :]
    decay = jnp.where(lower, jnp.exp(jnp.where(lower, rel, 0.0)), 0.0)
    if dg == 1:
        scores = jnp.einsum('bhnid,bhnjd->bhnij', q, k) * decay[..., 0]
    else:
        scores = jnp.einsum('bhnid,bhnjd,bhnijd->bhnij', q, k, decay)
    o_intra = jnp.einsum('bhnij,bhnjv->bhniv', scores, v)
    q_in = q * jnp.exp(cum)
    k_out = k * jnp.exp(last - cum)
    d_state = jnp.einsum('bhnid,bhniv->bhndv', k_out, v)
    chunk_decay = jnp.exp(last[:, :, :, 0, :])

    def step(state, inp):
        g_c, ds_c = inp
        return g_c[..., None] * state + ds_c, state

    init = jnp.zeros((b, h, dk, dv), q.dtype)
    _, prev = lax.scan(step, init, (jnp.moveaxis(chunk_decay, 2, 0), jnp.moveaxis(d_state, 2, 0)))
    prev = jnp.moveaxis(prev, 0, 2)
    o_inter = jnp.einsum('bhnid,bhndv->bhniv', q_in, prev)
    return (o_intra + o_inter).reshape(b, h, s, dv)


def bidir_scan(q, k_f, k_b, v, la_f, la_b, chunk):
    flip = lambda t: jnp.flip(t, axis=2)
    fwd = chunk_gated_scan(q, k_f, v, la_f, chunk)
    bwd = chunk_gated_scan(flip(q), flip(k_b), flip(v), flip(la_b), chunk)
    return fwd + flip(bwd)


def gla_mixer(q, k, v, r, lr_f, lr_b, wa2, ba, norm_g):
    q = to_heads(q, GLA_HEADS)
    k = to_heads(k, GLA_HEADS) * (GLA_DK ** -0.5)
    v = to_heads(v, GLA_HEADS)

    def log_gate(lr, d):
        z = jnp.einsum('bsr,rk->bsk', lr, wa2[d]) + ba[d]
        return to_heads(jax.nn.log_sigmoid(z.astype(F32)) / GLA_GATE_NORM, GLA_HEADS)

    o = bidir_scan(q, k, k, v, log_gate(lr_f, 0), log_gate(lr_b, 1), GLA_CHUNK)
    o = head_rmsnorm(from_heads(o), norm_g)
    return o * jax.nn.silu(r.astype(F32))


def hgrn_lower_bounds(lb_logits):
    p = jax.nn.softmax(lb_logits.astype(F32), axis=1)
    return jnp.cumsum(p, axis=1) - p[:, :1]


def hgrn2_mixer(q, z_f, z_b, i, g, lb_f, lb_b, norm_g):
    q = jax.nn.silu(to_heads(q, HGRN_HEADS))
    v = to_heads(i, HGRN_HEADS)

    def gate(z, lb):
        z = z.astype(F32)
        f = lb + (1.0 - lb) * jax.nn.sigmoid(z)
        log_f = jnp.log(jnp.maximum(f, HGRN_MIN_F))
        key = (1.0 - lb) * jax.nn.sigmoid(-z)
        return to_heads(log_f, HGRN_HEADS), to_heads(key, HGRN_HEADS)

    la_f, k_f = gate(z_f, lb_f)
    la_b, k_b = gate(z_b, lb_b)
    o = bidir_scan(q, k_f, k_b, v, la_f, la_b, HGRN_CHUNK)
    o = head_rmsnorm(from_heads(o), norm_g)
    return o * jax.nn.silu(g.astype(F32))


def rotary(t):
    s, d = t.shape[2], t.shape[3]
    half = d // 2
    inv = ROPE_BASE ** (-jnp.arange(half, dtype=F32) / half)
    ang = jnp.arange(s, dtype=F32)[:, None] * inv[None, :]
    cos, sin = jnp.cos(ang), jnp.sin(ang)
    t1, t2 = t[..., :half], t[..., half:]
    return jnp.concatenate([t1 * cos - t2 * sin, t1 * sin + t2 * cos], axis=-1)


def retention_mixer(q, k, v, g, norm_g):
    q = rotary(to_heads(q, RET_HEADS))
    k = rotary(to_heads(k, RET_HEADS)) * (RET_DK ** -0.5)
    v = to_heads(v, RET_HEADS)
    b, h, s, _ = q.shape
    hidx = jnp.arange(RET_HEADS, dtype=F32)
    log_gamma_f = jnp.log1p(-jnp.exp2(-5.0 - hidx))
    log_gamma_b = jnp.log1p(-jnp.exp2(-5.5 - hidx))
    la_f = jnp.broadcast_to(log_gamma_f[None, :, None, None], (b, h, s, 1))
    la_b = jnp.broadcast_to(log_gamma_b[None, :, None, None], (b, h, s, 1))
    o = bidir_scan(q, k, k, v, la_f, la_b, RET_CHUNK)
    o = head_groupnorm(from_heads(o), norm_g)
    return o * jax.nn.silu(g.astype(F32))


def _complex_affine_combine(e1, e2):
    a1r, a1i, b1r, b1i = e1
    a2r, a2i, b2r, b2i = e2
    return (a1r * a2r - a1i * a2i,
            a1r * a2i + a1i * a2r,
            a2r * b1r - a2i * b1i + b2r,
            a2r * b1i + a2i * b1r + b2i)


def _s5_direction(ug, lam_re, lam_im, log_dt, b_re, b_im, reverse):
    s = ug.shape[1]
    lr = jnp.minimum(lam_re.astype(F32), -1e-4)
    li = lam_im.astype(F32)
    dt = jnp.exp(log_dt.astype(F32))[:, None]
    mag = jnp.exp(lr * dt)
    ar, ai = mag * jnp.cos(li * dt), mag * jnp.sin(li * dt)
    den = lr * lr + li * li
    nr = ar - 1.0
    cr = (nr * lr + ai * li) / den
    ci = (ai * lr - nr * li) / den
    br, bi = b_re.astype(F32), b_im.astype(F32)
    bbr = cr[..., None] * br - ci[..., None] * bi
    bbi = cr[..., None] * bi + ci[..., None] * br
    xr = jnp.einsum('bsgp,gnp->bsgn', ug, bbr)
    xi = jnp.einsum('bsgp,gnp->bsgn', ug, bbi)
    g_, n_ = ar.shape
    a_r = jnp.broadcast_to(ar[None, None], (1, s, g_, n_))
    a_i = jnp.broadcast_to(ai[None, None], (1, s, g_, n_))
    _, _, sr, si = lax.associative_scan(_complex_affine_combine, (a_r, a_i, xr, xi), reverse=reverse, axis=1)
    return sr, si


def s5_mixer(u, lam_re, lam_im, log_dt, b_re, b_im, c_re, c_im, d_skip, glu_w, glu_b):
    bsz, s, _ = u.shape
    uf = u.astype(F32)
    ug = uf.reshape(bsz, s, S5_GROUPS, S5_GROUP_CH)
    fr, fi = _s5_direction(ug, lam_re[0], lam_im[0], log_dt[0], b_re, b_im, False)
    rr, ri = _s5_direction(ug, lam_re[1], lam_im[1], log_dt[1], b_re, b_im, True)
    hr, hi = fr + rr, fi + ri
    y = (jnp.einsum('bsgn,gpn->bsgp', hr, c_re.astype(F32))
         - jnp.einsum('bsgn,gpn->bsgp', hi, c_im.astype(F32)))
    y = y.reshape(bsz, s, S5_WIDTH) + d_skip.astype(F32) * uf
    g = jax.nn.gelu(y)
    return g * jax.nn.sigmoid(jnp.einsum('bsc,ce->bse', g, glu_w.astype(F32)) + glu_b.astype(F32))


def even_mixer(h, w_in, w_out, wa2, ba, gla_g, lb_f, lb_b, hgrn_g):
    p = jnp.einsum('bsd,de->bse', h, w_in)
    gq, gk, gv, gr, glf, glb, hq, hzf, hzb, hi, hg = _split(p, EVEN_COLS)
    a = gla_mixer(gq, gk, gv, gr, glf, glb, wa2, ba, gla_g)
    bm = hgrn2_mixer(hq, hzf, hzb, hi, hg, lb_f, lb_b, hgrn_g)
    y = jnp.concatenate([a, bm], axis=-1).astype(h.dtype)
    return jnp.einsum('bse,ed->bsd', y, w_out)


def odd_mixer(h, w_in, w_out, ret_g, lam_re, lam_im, log_dt, b_re, b_im, c_re, c_im, d_skip, glu_w, glu_b):
    p = jnp.einsum('bsd,de->bse', h, w_in)
    rq, rk, rv, rg, su = _split(p, ODD_COLS)
    c = retention_mixer(rq, rk, rv, rg, ret_g)
    dm = s5_mixer(su, lam_re, lam_im, log_dt, b_re, b_im, c_re, c_im, d_skip, glu_w, glu_b)
    y = jnp.concatenate([c, dm], axis=-1).astype(h.dtype)
    return jnp.einsum('bse,ed->bsd', y, w_out)


def conv_ffn(h, w_up, conv_w, conv_b, w_down):
    u = jnp.einsum('bsd,df->bsf', h, w_up)
    s = u.shape[1]
    pad = CONV_WIDTH // 2
    up = jnp.pad(u, ((0, 0), (pad, pad), (0, 0)))
    c = conv_b + up[:, 0:s] * conv_w[0]
    for t in range(1, CONV_WIDTH):
        c = c + up[:, t:t + s] * conv_w[t]
    a, v = jnp.split(c, 2, axis=-1)
    return jnp.einsum('bsf,fd->bsd', jax.nn.silu(a) * v, w_down)


def setup_inputs(seed: int = 0) -> dict:
    key = jax.random.key(seed)
    keys = iter(jax.random.split(key, 40))

    def nrm(shape, scale=1.0):
        return scale * jax.random.normal(next(keys), shape, F32)

    def gain(shape):
        return 1.0 + 0.01 * nrm(shape)

    gla_hk = GLA_HEADS * GLA_DK
    hgrn_hk = HGRN_HEADS * HGRN_DK
    x = nrm((BATCH, SEQ, D_MODEL))
    mix_norm_g = gain((DEPTH, D_MODEL))
    ffn_norm_g = gain((DEPTH, D_MODEL))
    final_norm_g = gain((D_MODEL,))
    w_in_even = nrm((N_EVEN, D_MODEL, EVEN_IN), D_MODEL ** -0.5)
    w_out_even = nrm((N_EVEN, EVEN_MIX, D_MODEL), EVEN_MIX ** -0.5)
    gla_wa2 = nrm((N_EVEN, 2, GLA_RANK, gla_hk), GLA_RANK ** -0.5)
    gla_ba = nrm((N_EVEN, 2, gla_hk), 0.1)
    gla_norm_g = gain((N_EVEN, GLA_HEADS * GLA_DV))
    hgrn_lb_logits = nrm((2, N_EVEN, hgrn_hk), 0.1)
    hgrn_norm_g = gain((N_EVEN, HGRN_HEADS * HGRN_DV))
    w_in_odd = nrm((N_ODD, D_MODEL, ODD_IN), D_MODEL ** -0.5)
    w_out_odd = nrm((N_ODD, ODD_MIX, D_MODEL), ODD_MIX ** -0.5)
    ret_norm_g = gain((N_ODD, RET_HEADS * RET_DV))
    s5_lam_re = -0.5 + 0.01 * nrm((N_ODD, 2, S5_GROUPS, S5_STATE))
    s5_lam_im = jnp.pi * jnp.arange(S5_STATE, dtype=F32) + 0.01 * nrm((N_ODD, 2, S5_GROUPS, S5_STATE))
    s5_log_dt = jax.random.uniform(next(keys), (N_ODD, 2, S5_GROUPS), F32, math.log(1e-3), math.log(1e-1))
    s5_b_re = nrm((N_ODD, S5_GROUPS, S5_STATE, S5_GROUP_CH), (2.0 * S5_GROUP_CH) ** -0.5)
    s5_b_im = nrm((N_ODD, S5_GROUPS, S5_STATE, S5_GROUP_CH), (2.0 * S5_GROUP_CH) ** -0.5)
    s5_c_re = nrm((N_ODD, S5_GROUPS, S5_GROUP_CH, S5_STATE), S5_STATE ** -0.5)
    s5_c_im = nrm((N_ODD, S5_GROUPS, S5_GROUP_CH, S5_STATE), S5_STATE ** -0.5)
    s5_d = nrm((N_ODD, S5_WIDTH))
    s5_glu_w = nrm((N_ODD, S5_WIDTH, S5_WIDTH), S5_WIDTH ** -0.5)
    s5_glu_b = nrm((N_ODD, S5_WIDTH), 0.01)
    ffn_w_up = nrm((DEPTH, D_MODEL, 2 * FFN_DIM), D_MODEL ** -0.5)
    ffn_conv_w = nrm((DEPTH, CONV_WIDTH, 2 * FFN_DIM), CONV_WIDTH ** -0.5)
    ffn_conv_b = nrm((DEPTH, 2 * FFN_DIM), 0.01)
    ffn_w_down = nrm((DEPTH, FFN_DIM, D_MODEL), FFN_DIM ** -0.5)
    return {'x': x, 'mix_norm_g': mix_norm_g, 'ffn_norm_g': ffn_norm_g, 'final_norm_g': final_norm_g,
            'w_in_even': w_in_even, 'w_out_even': w_out_even, 'gla_wa2': gla_wa2, 'gla_ba': gla_ba,
            'gla_norm_g': gla_norm_g, 'hgrn_lb_logits': hgrn_lb_logits, 'hgrn_norm_g': hgrn_norm_g,
            'w_in_odd': w_in_odd, 'w_out_odd': w_out_odd, 'ret_norm_g': ret_norm_g,
            's5_lam_re': s5_lam_re, 's5_lam_im': s5_lam_im, 's5_log_dt': s5_log_dt,
            's5_b_re': s5_b_re, 's5_b_im': s5_b_im, 's5_c_re': s5_c_re, 's5_c_im': s5_c_im,
            's5_d': s5_d, 's5_glu_w': s5_glu_w, 's5_glu_b': s5_glu_b,
            'ffn_w_up': ffn_w_up, 'ffn_conv_w': ffn_conv_w, 'ffn_conv_b': ffn_conv_b, 'ffn_w_down': ffn_w_down}


def reference(x, mix_norm_g, ffn_norm_g, final_norm_g,
              w_in_even, w_out_even, gla_wa2, gla_ba, gla_norm_g, hgrn_lb_logits, hgrn_norm_g,
              w_in_odd, w_out_odd, ret_norm_g, s5_lam_re, s5_lam_im, s5_log_dt,
              s5_b_re, s5_b_im, s5_c_re, s5_c_im, s5_d, s5_glu_w, s5_glu_b,
              ffn_w_up, ffn_conv_w, ffn_conv_b, ffn_w_down):
    lbs = hgrn_lower_bounds(hgrn_lb_logits)
    for layer in range(DEPTH):
        j = layer // 2
        h = rmsnorm(x, mix_norm_g[layer])
        if layer % 2 == 0:
            mix = even_mixer(h, w_in_even[j], w_out_even[j], gla_wa2[j], gla_ba[j], gla_norm_g[j],
                             lbs[0, j], lbs[1, j], hgrn_norm_g[j])
        else:
            mix = odd_mixer(h, w_in_odd[j], w_out_odd[j], ret_norm_g[j], s5_lam_re[j], s5_lam_im[j],
                            s5_log_dt[j], s5_b_re[j], s5_b_im[j], s5_c_re[j], s5_c_im[j], s5_d[j],
                            s5_glu_w[j], s5_glu_b[j])
        x = x + mix.astype(x.dtype)
        hf = rmsnorm(x, ffn_norm_g[layer])
        x = x + conv_ffn(hf, ffn_w_up[layer], ffn_conv_w[layer], ffn_conv_b[layer], ffn_w_down[layer]).astype(x.dtype)
    return rmsnorm(x, final_norm_g)
```

```cpp
#include <hip/hip_runtime.h>
#include <hip/hip_cooperative_groups.h>
#include <cstdio>
namespace cg = cooperative_groups;

typedef unsigned short bf16_t;
typedef short bf16x8 __attribute__((ext_vector_type(8)));
typedef float f32x4 __attribute__((ext_vector_type(4)));

#ifndef MULTI_LAUNCH
#define MULTI_LAUNCH 0
#endif
#ifndef PROBE_MODE
#define PROBE_MODE 0
#endif

constexpr int TOK = 32768, SEQ = 2048, NBATCH = 16, DM = 1024;
constexpr float EPS = 1e-6f;
constexpr int EVEN_INP = 3584;
constexpr int ODD_IN = 2816;
constexpr int FFN = 2816;
__device__ __forceinline__ int ffn_c0(int h) { return h ? 1536 : 0; }
__device__ __forceinline__ int ffn_n(int h) { return h ? 1280 : 1536; }
constexpr int E_GQ = 0, E_GK = 256, E_GV = 512, E_GR = 1024, E_GLF = 1536, E_GLB = 1552, E_HQ = 1568, E_HZF = 1824, E_HZB = 2080, E_HI = 2336, E_HG = 2848;
constexpr int O_RQ = 0, O_RK = 512, O_RV = 1024, O_RG = 1792, O_SU = 2560;

constexpr size_t OFF_A16 = 0;
constexpr size_t OFF_OFB = 67108864;
constexpr size_t OFF_PU = 201326592;
constexpr size_t OFF_WB = 436207616;
constexpr size_t OFF_S5M = 463077376;
constexpr size_t OFF_MISC = 513409024;
constexpr size_t OFF_BAR = 516538368;
constexpr size_t WS_NEEDED = 516538368 + 8192;
constexpr size_t OFB_OB_EVEN = 67108864;
constexpr size_t OFB_OB_ODD = 50331648;
constexpr size_t OFB_U2 = 100663296;
constexpr size_t OFB_DST = 121634816;
constexpr size_t PU_G = 184549376;
constexpr size_t WB_IN = 0, WB_OUT = 3670016, WB_UP = 4718592, WB_DOWN = 10485760, WB_GLU = 13369344;
constexpr size_t S5M_PM = 41943040;
constexpr size_t MISC_ROPE = 2080768;

struct Params {
  const float* in[28];
  float* out;
  char* ws;
};


__device__ __forceinline__ int TIDX(int swave) {
  int t = swave * 64 + (int)__builtin_amdgcn_mbcnt_hi(~0u, __builtin_amdgcn_mbcnt_lo(~0u, 0u));
  asm volatile("" : "+v"(t)); return t; }
__device__ __forceinline__ int BIDX() { int t = blockIdx.x; asm volatile("" : "+s"(t)); return t; }
__device__ __forceinline__ size_t opaque0() { size_t z = 0; asm volatile("" : "+s"(z)); return z; }
__device__ __forceinline__ const float* INP(const Params& p, int k) { return p.in[k] + opaque0(); }
__device__ __forceinline__ char* WS(const Params& p) { return p.ws + opaque0(); }
__device__ __forceinline__ float* OUTP(const Params& p) { return p.out + opaque0(); }

typedef unsigned u32x4_t __attribute__((ext_vector_type(4)));
typedef unsigned u32x2_t __attribute__((ext_vector_type(2)));
__device__ __forceinline__ uint4 ld_nt16(const void* p) { const u32x4_t t = __builtin_nontemporal_load((const u32x4_t*)p); return make_uint4(t[0], t[1], t[2], t[3]); }
__device__ __forceinline__ uint2 ld_nt8(const void* p) { const u32x2_t t = __builtin_nontemporal_load((const u32x2_t*)p); return make_uint2(t[0], t[1]); }
__device__ __forceinline__ float4 ld_nt16f(const void* p) { const f32x4 t = __builtin_nontemporal_load((const f32x4*)p); return make_float4(t[0], t[1], t[2], t[3]); }
__device__ __forceinline__ void lds_barrier() {
  asm volatile("s_waitcnt lgkmcnt(0)" ::: "memory");
  __builtin_amdgcn_s_barrier();
  asm volatile("" ::: "memory");
}
__device__ __forceinline__ float bf2f(bf16_t v) { return __uint_as_float(((unsigned)v) << 16); }
typedef float f32x2_t __attribute__((ext_vector_type(2)));
typedef __bf16 bf16x2_t __attribute__((ext_vector_type(2)));
__device__ __forceinline__ unsigned pk2(float lo, float hi) { f32x2_t v = {lo, hi}; bf16x2_t b = __builtin_convertvector(v, bf16x2_t); return __builtin_bit_cast(unsigned, b); }
__device__ __forceinline__ bf16_t f2bf(float f) { return (bf16_t)(pk2(f, 0.f) & 0xffffu); }
__device__ __forceinline__ float lo_bf(unsigned u) { return __uint_as_float(u << 16); }
__device__ __forceinline__ float hi_bf(unsigned u) { return __uint_as_float(u & 0xffff0000u); }
__device__ __forceinline__ float sigmoidf_(float x) { return __builtin_amdgcn_rcpf(1.f + __expf(-x)); }
__device__ __forceinline__ float siluf_(float x) { return x * __builtin_amdgcn_rcpf(1.f + __expf(-x)); }
__device__ __forceinline__ float wave_sum(float v, int lane) {
#pragma unroll
  for (int o = 32; o > 0; o >>= 1) v += __int_as_float(__builtin_amdgcn_ds_bpermute((lane ^ o) << 2, __float_as_int(v)));
  return v;
}
__device__ __forceinline__ float gelu_tanh(float x) {
  float u = 0.7978845608028654f * (x + 0.044715f * x * x * x);
  float t = 1.f - 2.f * __builtin_amdgcn_rcpf(__expf(2.f * u) + 1.f);
  return 0.5f * x * (1.f + t);
}
__device__ __forceinline__ void cis_d(double ang, float& c, float& s) {
  double k = rint(ang * 0.15915494309189535);
  float r = (float)(ang - k * 6.283185307179586);
  c = __cosf(r); s = __sinf(r);
}

constexpr int HTB = 16384;
__device__ __forceinline__ int lds_byte(int r, int c) {
  int st = (r >> 4) * 2 + (c >> 5), rr = r & 15, cc = c & 31, ob = rr * 64 + cc * 2;
  return st * 1024 + (ob ^ (((ob >> 9) & 1) << 5));
}
__device__ __forceinline__ void stage_rc(int b, int& R, int& C) {
  int st = b / 1024, sb = b % 1024, swz = sb ^ (((sb >> 9) & 1) << 5);
  R = (st >> 1) * 16 + swz / 64; C = (st & 1) * 32 + (swz % 64) / 2;
}
typedef __attribute__((address_space(3))) unsigned lds_u32;

template <class Epi>
__device__ __forceinline__ void gemm_tile(int swave, const bf16_t* __restrict__ A, int lda, const bf16_t* __restrict__ A1, int lda1, int ksplit, const bf16_t* __restrict__ Bt, int ldb, int K,
                                          int brow, int bcol, char* shm, const Epi& epi) {
  const int tidx = TIDX(swave);
#define SA(b, h) (shm + ((b) * 2 + (h)) * HTB)
#define SB(b, h) (shm + (4 + (b) * 2 + (h)) * HTB)
#define STAGE(P, BASE, LD, O0, O1, br, kt) do { const bf16_t* _g = (BASE) + ((size_t)(br) * (LD) + (size_t)(kt) * 64); \
    __builtin_amdgcn_global_load_lds((const unsigned*)(_g + O0), (lds_u32*)((P) + swave * 1024), 16, 0, 0); \
    __builtin_amdgcn_global_load_lds((const unsigned*)(_g + (size_t)64 * (LD) + O0), (lds_u32*)((P) + swave * 1024 + 8192), 16, 0, 0); } while (0)
#define STAGEA(P, br, kt) do { const int _kt = (kt); const bool _s = _kt >= ksplit; const int _ld = _s ? lda1 : lda; \
    const bf16_t* _g = (_s ? A1 : A) + ((size_t)(br) * _ld + (size_t)(_s ? _kt - ksplit : _kt) * 64); const unsigned _o = _s ? offA1 : offA0; \
    __builtin_amdgcn_global_load_lds((const unsigned*)(_g + _o), (lds_u32*)((P) + swave * 1024), 16, 0, 0); \
    __builtin_amdgcn_global_load_lds((const unsigned*)(_g + (size_t)64 * _ld + _o), (lds_u32*)((P) + swave * 1024 + 8192), 16, 0, 0); } while (0)
#define LDA(dst, b, h) for (int m = 0; m < 4; ++m) for (int k = 0; k < 2; ++k) \
    dst[m][k] = *reinterpret_cast<const bf16x8*>(SA(b, h) + lds_byte(wr * 64 + m * 16 + fr, k * 32 + fq * 8))
#define LDB(dst, b, h) for (int n = 0; n < 2; ++n) for (int k = 0; k < 2; ++k) \
    dst[n][k] = *reinterpret_cast<const bf16x8*>(SB(b, h) + lds_byte(wc * 32 + n * 16 + fr, k * 32 + fq * 8))
#define MMA(ai, bj, At_, Bt_) do { __builtin_amdgcn_s_setprio(1); \
    for (int m = 0; m < 4; ++m) for (int n = 0; n < 2; ++n) for (int k = 0; k < 2; ++k) \
      acc[ai][bj][m][n] = __builtin_amdgcn_mfma_f32_16x16x32_bf16(Bt_[n][k], At_[m][k], acc[ai][bj][m][n], 0, 0, 0); \
    __builtin_amdgcn_s_setprio(0); } while (0)
#define WAIT_V(n) asm volatile("s_waitcnt vmcnt(" #n ")" ::: "memory")
#define WAIT_L(n) asm volatile("s_waitcnt lgkmcnt(" #n ")" ::: "memory")
#define BAR __builtin_amdgcn_s_barrier()
#define SCHED __builtin_amdgcn_sched_barrier(0)
  const int wid = tidx >> 6, lane = tidx & 63, wr = wid >> 2, wc = wid & 3, fr = lane & 15, fq = lane >> 4;
  f32x4 acc[2][2][4][2] = {};
  bf16x8 At[4][2], B0[2][2], B1[2][2];
  const int nt = K / 64;
  unsigned offA0, offA1, offB0;
  { int _r, _c; stage_rc(tidx * 16, _r, _c); offA0 = _r * lda + _c; offA1 = _r * lda1 + _c; offB0 = _r * ldb + _c; }
  STAGE(SB(0, 0), Bt, ldb, offB0, 0, bcol, 0); STAGEA(SA(0, 0), brow, 0);
  STAGE(SB(0, 1), Bt, ldb, offB0, 0, bcol + 128, 0); STAGEA(SA(0, 1), brow + 128, 0);
  if (wr == 1) BAR;
  WAIT_V(4); BAR;
  STAGE(SB(1, 0), Bt, ldb, offB0, 0, bcol, 1); STAGEA(SA(1, 0), brow, 1); STAGE(SB(1, 1), Bt, ldb, offB0, 0, bcol + 128, 1);
  WAIT_V(6); BAR;
  for (int t = 0; t < nt - 2; t += 2) {
    LDB(B0, 0, 0); SCHED; LDA(At, 0, 0); STAGEA(SA(1, 1), brow + 128, t + 1);
    WAIT_L(8); BAR; WAIT_L(0); MMA(0, 0, At, B0); BAR; SCHED;
    LDB(B1, 0, 1); STAGE(SB(0, 0), Bt, ldb, offB0, 0, bcol, t + 2);
    BAR; WAIT_L(0); MMA(0, 1, At, B1); BAR;
    LDA(At, 0, 1); STAGEA(SA(0, 0), brow, t + 2);
    BAR; WAIT_L(0); MMA(1, 0, At, B0); BAR; SCHED;
    STAGE(SB(0, 1), Bt, ldb, offB0, 0, bcol + 128, t + 2);
    WAIT_V(6); BAR; MMA(1, 1, At, B1); BAR;
    LDB(B0, 1, 0); SCHED; LDA(At, 1, 0); STAGEA(SA(0, 1), brow + 128, t + 2);
    WAIT_L(8); BAR; WAIT_L(0); MMA(0, 0, At, B0); BAR; SCHED;
    LDB(B1, 1, 1); STAGE(SB(1, 0), Bt, ldb, offB0, 0, bcol, t + 3);
    BAR; WAIT_L(0); MMA(0, 1, At, B1); BAR;
    LDA(At, 1, 1); STAGEA(SA(1, 0), brow, t + 3);
    BAR; WAIT_L(0); MMA(1, 0, At, B0); BAR; SCHED;
    STAGE(SB(1, 1), Bt, ldb, offB0, 0, bcol + 128, t + 3);
    WAIT_V(6); BAR; MMA(1, 1, At, B1); BAR;
  }
  { LDB(B0, 0, 0); LDA(At, 0, 0); STAGEA(SA(1, 1), brow + 128, nt - 1);
    BAR; WAIT_L(0); MMA(0, 0, At, B0); BAR;
    LDB(B1, 0, 1); BAR; WAIT_L(0); MMA(0, 1, At, B1); BAR;
    LDA(At, 0, 1); WAIT_V(4); BAR; WAIT_L(0); MMA(1, 0, At, B0); MMA(1, 1, At, B1); BAR; }
  { LDB(B0, 1, 0); LDA(At, 1, 0); WAIT_V(2); BAR; WAIT_L(0); MMA(0, 0, At, B0); BAR;
    LDB(B1, 1, 1); WAIT_V(0); BAR; WAIT_L(0); MMA(0, 1, At, B1); BAR;
    LDA(At, 1, 1); BAR; WAIT_L(0); MMA(1, 0, At, B0); MMA(1, 1, At, B1); BAR; }
  if (wr == 0) BAR;
#pragma unroll
  for (int ai = 0; ai < 2; ++ai)
#pragma unroll
    for (int m = 0; m < 4; ++m)
#pragma unroll
      for (int bj = 0; bj < 2; ++bj)
#pragma unroll
        for (int n = 0; n < 2; ++n)
          epi(brow + ai * 128 + wr * 64 + m * 16 + fr, bcol + bj * 128 + wc * 32 + n * 16 + fq * 4, acc[ai][bj][m][n]);
#undef SA
#undef SB
#undef STAGE
#undef STAGEA
#undef LDA
#undef LDB
#undef MMA
}

__device__ __forceinline__ void tile_map(int wgid, int nM, int nN, int& pm, int& pn) {
  const int nwg = nM * nN;
  { const int q = nwg / 8, r = nwg % 8, xcd = wgid % 8, off = wgid / 8; wgid = (xcd < r ? xcd * (q + 1) : r * (q + 1) + (xcd - r) * q) + off; }
  const int nig = 8 * nN, gid = wgid / nig, fm = gid * 8, gsz = (nM - fm) < 8 ? (nM - fm) : 8;
  pm = fm + ((wgid % nig) % gsz); pn = (wgid % nig) / gsz;
}

struct GemmJob {
  const bf16_t* A; const bf16_t* Bt; size_t strideA, strideB, strideC;
  int lda, ldb, K, nM, nN, nb, epi, ldc;
  void* c0; const void* c1; const void* c2;
  const bf16_t* A1; int lda1, ksplit;
};
struct EpiAny {
  int epi, ldc, g; void* c0; const void* c1; const void* c2;
  __device__ __forceinline__ void pair(int row, int col, f32x4 v0, f32x4 v1) const {
    if (epi == 0) {
      uint4 o; o.x = pk2(v0[0], v0[1]); o.y = pk2(v0[2], v0[3]); o.z = pk2(v1[0], v1[1]); o.w = pk2(v1[2], v1[3]);
      *(uint4*)((bf16_t*)c0 + (size_t)row * ldc + col) = o;
    } else { (*this)(row, col, v0); (*this)(row, col + 4, v1); }
  }
  __device__ __forceinline__ void operator()(int row, int col, f32x4 v) const {
    if (epi == 0) {
      uint2 o; o.x = pk2(v[0], v[1]); o.y = pk2(v[2], v[3]);
      *(uint2*)((bf16_t*)c0 + (size_t)row * ldc + col) = o;
    } else if (epi == 1) {
      f32x4 s = *(const f32x4*)((const float*)c1 + (size_t)row * DM + col);
      *(f32x4*)((float*)c0 + (size_t)row * DM + col) = s + v;
    } else if (epi == 2) {
      *(f32x4*)((float*)c0 + (size_t)row * ldc + col) = v;
    } else if (epi == 3) {
      size_t token = (size_t)row * 64 + (col >> 4);
      uint2 o; o.x = pk2(gelu_tanh(v[0]), gelu_tanh(v[1])); o.y = pk2(gelu_tanh(v[2]), gelu_tanh(v[3]));
      *(uint2*)((bf16_t*)c0 + token * 256 + g * 16 + (col & 15)) = o;
    } else {
      uint2 gg = *(const uint2*)((const bf16_t*)c1 + (size_t)row * 256 + col);
      f32x4 bb = *(const f32x4*)((const float*)c2 + col);
      float g0 = lo_bf(gg.x), g1 = hi_bf(gg.x), g2 = lo_bf(gg.y), g3 = hi_bf(gg.y);
      uint2 o; o.x = pk2(g0 * sigmoidf_(v[0] + bb[0]), g1 * sigmoidf_(v[1] + bb[1]));
      o.y = pk2(g2 * sigmoidf_(v[2] + bb[2]), g3 * sigmoidf_(v[3] + bb[3]));
      *(uint2*)((bf16_t*)c0 + (size_t)row * DM + 768 + col) = o;
    }
  }
};
__device__ __forceinline__ void gemm_run_tiles(int swave, const GemmJob& J, char* shm, int vb, int G) {
  const int per = J.nM * J.nN, ntile = per * J.nb;
  for (int id = vb; id < ntile; id += G) {
    int g = 0, pm, pn;
    if (J.nb == 1) tile_map(id, J.nM, J.nN, pm, pn);
    else { g = id / per; const int rem = id - g * per; pm = rem / J.nN; pn = rem - pm * J.nN; }
    EpiAny e{J.epi, J.ldc, g, (void*)((char*)J.c0 + (size_t)g * J.strideC), J.c1, J.c2};
    gemm_tile(swave, J.A + (size_t)g * J.strideA, J.lda, J.A1 + (size_t)g * J.strideA, J.lda1, J.ksplit, J.Bt + (size_t)g * J.strideB, J.ldb, J.K, pm * 256, pn * 256, shm, e);
  }
}

__device__ __forceinline__ int perm32(int rho) { const int n = rho >> 4, i = rho & 15; return 8 * (i >> 2) + 4 * n + (i & 3); }
__device__ __forceinline__ void gemm_stream(int swave, const GemmJob& J, char* shm, int vb, int G) {
  const int tidx = TIDX(swave);
  const int per = J.nM * J.nN, ntile = per * J.nb;
  if (vb >= ntile) return;
  const int lda = J.lda, lda1 = J.lda1, ksplit = J.ksplit, ldb = J.ldb, K = J.K, nt = K / 64;
#define SA(b, h) (shm + ((b) * 2 + (h)) * HTB)
#define SB(b, h) (shm + (4 + (b) * 2 + (h)) * HTB)
#define STG(P, PTR, LD, O0) do { const bf16_t* _g = (PTR); \
    __builtin_amdgcn_global_load_lds((const unsigned*)(_g + O0), (lds_u32*)((P) + swave * 1024), 16, 0, 0); \
    __builtin_amdgcn_global_load_lds((const unsigned*)(_g + (size_t)64 * (LD) + O0), (lds_u32*)((P) + swave * 1024 + 8192), 16, 0, 0); } while (0)
#define STGA(P, B0_, B1_, kt, half) do { const int _kt = (kt); const bool _s = _kt >= ksplit; const int _ld = _s ? lda1 : lda; \
    const bf16_t* _g = (_s ? (B1_) + (size_t)(_kt - ksplit) * 64 : (B0_) + (size_t)_kt * 64) + ((half) ? (size_t)128 * _ld : (size_t)0); const unsigned _o = _s ? offA1 : offA0; \
    __builtin_amdgcn_global_load_lds((const unsigned*)(_g + _o), (lds_u32*)((P) + swave * 1024), 16, 0, 0); \
    __builtin_amdgcn_global_load_lds((const unsigned*)(_g + (size_t)64 * _ld + _o), (lds_u32*)((P) + swave * 1024 + 8192), 16, 0, 0); } while (0)
#define LDA(dst, b, h) for (int m = 0; m < 4; ++m) for (int k = 0; k < 2; ++k) \
    dst[m][k] = *reinterpret_cast<const bf16x8*>(SA(b, h) + lds_byte(wr * 64 + m * 16 + fr, k * 32 + fq * 8))
#define LDB(dst, b, h) for (int n = 0; n < 2; ++n) for (int k = 0; k < 2; ++k) \
    dst[n][k] = *reinterpret_cast<const bf16x8*>(SB(b, h) + lds_byte(wc * 32 + n * 16 + fr, k * 32 + fq * 8))
#define MMA(ai, bj, At_, Bt_) do { __builtin_amdgcn_s_setprio(1); \
    for (int m = 0; m < 4; ++m) for (int n = 0; n < 2; ++n) for (int k = 0; k < 2; ++k) \
      acc[ai][bj][m][n] = __builtin_amdgcn_mfma_f32_16x16x32_bf16(Bt_[n][k], At_[m][k], acc[ai][bj][m][n], 0, 0, 0); \
    __builtin_amdgcn_s_setprio(0); } while (0)
#define WAIT_V(n) asm volatile("s_waitcnt vmcnt(" #n ")" ::: "memory")
#define WAIT_L(n) asm volatile("s_waitcnt lgkmcnt(" #n ")" ::: "memory")
#define BAR __builtin_amdgcn_s_barrier()
#define SCHED __builtin_amdgcn_sched_barrier(0)
  const int wid = tidx >> 6, lane = tidx & 63, wr = wid >> 2, wc = wid & 3, fr = lane & 15, fq = lane >> 4;
  unsigned offA0, offA1, offB0;
  { int _r, _c; stage_rc(tidx * 16, _r, _c); offA0 = _r * lda + _c; offA1 = _r * lda1 + _c; const int _rb = (_r & ~31) + perm32(_r & 31); offB0 = _rb * ldb + _c; }
  const size_t hB = (size_t)128 * ldb;
  int cg, cbrow, cbcol; const bf16_t* cA; const bf16_t* cA1; const bf16_t* cB;
  auto decode = [&](int id, int& g, int& brow, int& bcol, const bf16_t*& pA, const bf16_t*& pA1, const bf16_t*& pB) {
    int pm, pn; g = 0;
    if (J.nb == 1) tile_map(id, J.nM, J.nN, pm, pn);
    else { g = id / per; const int rem = id - g * per; pm = rem / J.nN; pn = rem - pm * J.nN; }
    brow = pm * 256; bcol = pn * 256;
    pA = J.A + (size_t)g * J.strideA + (size_t)brow * lda; pA1 = J.A1 + (size_t)g * J.strideA + (size_t)brow * lda1; pB = J.Bt + (size_t)g * J.strideB + (size_t)bcol * ldb;
  };
  int id = vb;
  decode(id, cg, cbrow, cbcol, cA, cA1, cB);
  f32x4 acc[2][2][4][2] = {};
  bf16x8 At[4][2], B0[2][2], B1[2][2];
  STG(SB(0, 0), cB, ldb, offB0); STGA(SA(0, 0), cA, cA1, 0, 0); STG(SB(0, 1), cB + hB, ldb, offB0); STGA(SA(0, 1), cA, cA1, 0, 1);
  if (wr == 1) BAR;
  WAIT_V(4); BAR;
  STG(SB(1, 0), cB + 64, ldb, offB0); STGA(SA(1, 0), cA, cA1, 1, 0); STG(SB(1, 1), cB + hB + 64, ldb, offB0);
  WAIT_V(6); BAR;
  for (;;) {
    const int nid = id + G; const bool has_next = nid < ntile;
    int ng = cg, nbrow = cbrow, nbcol = cbcol; const bf16_t* nA = cA; const bf16_t* nA1 = cA1; const bf16_t* nB = cB;
    if (has_next) decode(nid, ng, nbrow, nbcol, nA, nA1, nB);
    for (int t = 0; t < nt; t += 2) {
      const bool last = (t == nt - 2);
      const bf16_t* xA = last ? nA : cA; const bf16_t* xA1 = last ? nA1 : cA1; const int k2 = last ? 0 : t + 2;
      const bf16_t* b2 = last ? nB : cB + (size_t)(t + 2) * 64; const bf16_t* b3 = b2 + 64;
      LDB(B0, 0, 0); SCHED; LDA(At, 0, 0); STGA(SA(1, 1), cA, cA1, t + 1, 1);
      WAIT_L(8); BAR; WAIT_L(0); MMA(0, 0, At, B0); BAR; SCHED;
      LDB(B1, 0, 1); STG(SB(0, 0), b2, ldb, offB0);
      BAR; WAIT_L(0); MMA(0, 1, At, B1); BAR;
      LDA(At, 0, 1); STGA(SA(0, 0), xA, xA1, k2, 0);
      BAR; WAIT_L(0); MMA(1, 0, At, B0); BAR; SCHED;
      STG(SB(0, 1), b2 + hB, ldb, offB0);
      WAIT_V(6); BAR; MMA(1, 1, At, B1); BAR;
      LDB(B0, 1, 0); SCHED; LDA(At, 1, 0); STGA(SA(0, 1), xA, xA1, k2, 1);
      WAIT_L(8); BAR; WAIT_L(0); MMA(0, 0, At, B0); BAR; SCHED;
      LDB(B1, 1, 1); STG(SB(1, 0), b3, ldb, offB0);
      BAR; WAIT_L(0); MMA(0, 1, At, B1); BAR;
      LDA(At, 1, 1); STGA(SA(1, 0), xA, xA1, k2 + 1, 0);
      BAR; WAIT_L(0); MMA(1, 0, At, B0); BAR; SCHED;
      STG(SB(1, 1), b3 + hB, ldb, offB0);
      WAIT_V(6); BAR; MMA(1, 1, At, B1); BAR;
    }
    {
      bf16_t* C = (bf16_t*)((char*)J.c0 + (size_t)cg * J.strideC);
#pragma unroll
      for (int ai = 0; ai < 2; ++ai)
#pragma unroll
        for (int m = 0; m < 4; ++m)
#pragma unroll
          for (int bj = 0; bj < 2; ++bj) {
            const f32x4 v0 = acc[ai][bj][m][0], v1 = acc[ai][bj][m][1];
            uint4 o; o.x = pk2(v0[0], v0[1]); o.y = pk2(v0[2], v0[3]); o.z = pk2(v1[0], v1[1]); o.w = pk2(v1[2], v1[3]);
            *(uint4*)(C + (size_t)(cbrow + ai * 128 + wr * 64 + m * 16 + fr) * J.ldc + cbcol + bj * 128 + wc * 32 + fq * 8) = o;
          }
    }
    if (!has_next) break;
#pragma unroll
    for (int a_ = 0; a_ < 2; ++a_)
#pragma unroll
      for (int b_ = 0; b_ < 2; ++b_)
#pragma unroll
        for (int m = 0; m < 4; ++m)
#pragma unroll
          for (int n = 0; n < 2; ++n) acc[a_][b_][m][n] = (f32x4){0.f, 0.f, 0.f, 0.f};
    id = nid; cg = ng; cbrow = nbrow; cbcol = nbcol; cA = nA; cA1 = nA1; cB = nB;
  }
  WAIT_V(0);
  if (wr == 0) BAR;
  BAR;
#undef SA
#undef SB
#undef STG
#undef STGA
#undef LDA
#undef LDB
#undef MMA
}
__device__ __forceinline__ void gemm_run(int swave, const GemmJob& J, char* shm, int vb, int G) {
  if (J.epi == 0) gemm_stream(swave, J, shm, vb, G);
  else gemm_run_tiles(swave, J, shm, vb, G);
}

__device__ __forceinline__ int transpose_tiles(int swave, const float* __restrict__ src, int lds_, int Kc, int Nc, bf16_t* __restrict__ dst, int ldd, char* shm, int job0) {
  const int tidx = TIDX(swave);
  const int bidx = BIDX();
  float* tile = (float*)shm;
  const int nkt = Kc / 64, nnt = (Nc + 63) / 64, ntile = nkt * nnt;
  const int tid = tidx;
  const int G = gridDim.x;
  int t0 = (bidx - job0 % G + G) % G;
  const int kk0 = tid >> 4, n4 = (tid & 15) * 4;
  float4 v0 = make_float4(0.f, 0.f, 0.f, 0.f), v1 = v0;
  auto issue = [&](int t, float4& a, float4& b) {
    const int kt = t % nkt, ntl = t / nkt, k0 = kt * 64, n0 = ntl * 64;
    a = make_float4(0.f, 0.f, 0.f, 0.f); b = a;
    if (n0 + n4 < Nc) { a = ld_nt16f(src + (size_t)(k0 + kk0) * lds_ + n0 + n4); b = ld_nt16f(src + (size_t)(k0 + kk0 + 32) * lds_ + n0 + n4); }
  };
  if (t0 < ntile) issue(t0, v0, v1);
  for (int t = t0; t < ntile; t += G) {
    const int kt = t % nkt, ntl = t / nkt, k0 = kt * 64, n0 = ntl * 64;
    lds_barrier();
    tile[kk0 * 65 + n4 + 0] = v0.x; tile[kk0 * 65 + n4 + 1] = v0.y; tile[kk0 * 65 + n4 + 2] = v0.z; tile[kk0 * 65 + n4 + 3] = v0.w;
    tile[(kk0 + 32) * 65 + n4 + 0] = v1.x; tile[(kk0 + 32) * 65 + n4 + 1] = v1.y; tile[(kk0 + 32) * 65 + n4 + 2] = v1.z; tile[(kk0 + 32) * 65 + n4 + 3] = v1.w;
    if (t + G < ntile) issue(t + G, v0, v1);
    lds_barrier();
    const int nn = tid >> 3, k8 = (tid & 7) * 8;
    if (n0 + nn < Nc) {
      uint4 o;
      o.x = pk2(tile[(k8 + 0) * 65 + nn], tile[(k8 + 1) * 65 + nn]);
      o.y = pk2(tile[(k8 + 2) * 65 + nn], tile[(k8 + 3) * 65 + nn]);
      o.z = pk2(tile[(k8 + 4) * 65 + nn], tile[(k8 + 5) * 65 + nn]);
      o.w = pk2(tile[(k8 + 6) * 65 + nn], tile[(k8 + 7) * 65 + nn]);
      *(uint4*)(dst + (size_t)(n0 + nn) * ldd + k0 + k8) = o;
    }
  }
  __syncthreads();
  return job0 + ntile;
}

__device__ __forceinline__ void rmsnorm_rows_bf16(int swave, const float* xsrc, const bf16_t* add, float* xdst, const float* g, bf16_t* out) {
  const int tidx = TIDX(swave);
  const int bidx = BIDX();
  const int wave = tidx >> 6, lane = tidx & 63;
  float4 gg[4];
#pragma unroll
  for (int u = 0; u < 4; ++u) gg[u] = ((const float4*)g)[lane + 64 * u];
  for (int row = (bidx * 8 + wave) * 2; row < TOK; row += gridDim.x * 16) {
    const float4* xr = (const float4*)(xsrc + (size_t)row * DM);
    float4 v[8]; float s0 = 0.f, s1 = 0.f;
#pragma unroll
    for (int u = 0; u < 8; ++u) { const f32x4 t = __builtin_nontemporal_load((const f32x4*)xr + lane + 64 * u); v[u] = make_float4(t[0], t[1], t[2], t[3]); }
    if (add) {
      const uint2* ar = (const uint2*)(add + (size_t)row * DM);
      uint2 av[8];
#pragma unroll
      for (int u = 0; u < 8; ++u) av[u] = ar[lane + 64 * u];
#pragma unroll
      for (int u = 0; u < 8; ++u) { v[u].x += lo_bf(av[u].x); v[u].y += hi_bf(av[u].x); v[u].z += lo_bf(av[u].y); v[u].w += hi_bf(av[u].y); }
      float4* xw = (float4*)(xdst + (size_t)row * DM);
#pragma unroll
      for (int u = 0; u < 8; ++u) { const f32x4 t = {v[u].x, v[u].y, v[u].z, v[u].w}; __builtin_nontemporal_store(t, (f32x4*)xw + lane + 64 * u); }
    }
#pragma unroll
    for (int u = 0; u < 4; ++u) {
      s0 += v[u].x * v[u].x + v[u].y * v[u].y + v[u].z * v[u].z + v[u].w * v[u].w;
      s1 += v[u + 4].x * v[u + 4].x + v[u + 4].y * v[u + 4].y + v[u + 4].z * v[u + 4].z + v[u + 4].w * v[u + 4].w;
    }
#pragma unroll
    for (int o = 32; o > 0; o >>= 1) {
      s0 += __int_as_float(__builtin_amdgcn_ds_bpermute((lane ^ o) << 2, __float_as_int(s0)));
      s1 += __int_as_float(__builtin_amdgcn_ds_bpermute((lane ^ o) << 2, __float_as_int(s1)));
    }
    const float r0 = rsqrtf(s0 * (1.f / DM) + EPS), r1 = rsqrtf(s1 * (1.f / DM) + EPS);
#pragma unroll
    for (int u = 0; u < 8; ++u) {
      const float r = u < 4 ? r0 : r1; const float4 g4 = gg[u & 3];
      uint2 o; o.x = pk2(v[u].x * r * g4.x, v[u].y * r * g4.y); o.y = pk2(v[u].z * r * g4.z, v[u].w * r * g4.w);
      *(uint2*)(out + (size_t)row * DM + (lane + 64 * u) * 4) = o;
    }
  }
}
__device__ __forceinline__ void final_norm(int swave, float* x, const bf16_t* add, const float* g) {
  const int tidx = TIDX(swave);
  const int bidx = BIDX();
  const int wave = tidx >> 6, lane = tidx & 63;
  for (int row = bidx * 8 + wave; row < TOK; row += gridDim.x * 8) {
    float4* xr = (float4*)(x + (size_t)row * DM);
    const uint2* ar = (const uint2*)(add + (size_t)row * DM);
    float4 v[4]; float ss = 0.f;
#pragma unroll
    for (int u = 0; u < 4; ++u) {
      v[u] = ld_nt16f(xr + lane + 64 * u); const uint2 a2 = ar[lane + 64 * u];
      v[u].x += lo_bf(a2.x); v[u].y += hi_bf(a2.x); v[u].z += lo_bf(a2.y); v[u].w += hi_bf(a2.y);
      ss += v[u].x * v[u].x + v[u].y * v[u].y + v[u].z * v[u].z + v[u].w * v[u].w;
    }
    ss = wave_sum(ss, lane);
    const float r = rsqrtf(ss * (1.f / DM) + EPS);
#pragma unroll
    for (int u = 0; u < 4; ++u) {
      float4 gg = ((const float4*)g)[lane + 64 * u];
      { const f32x4 t = {v[u].x * r * gg.x, v[u].y * r * gg.y, v[u].z * r * gg.z, v[u].w * r * gg.w}; __builtin_nontemporal_store(t, (f32x4*)xr + lane + 64 * u); }
    }
  }
}

__device__ void s5_tables(int swave, const Params& p, int j, int bidx, int nblk) {
  const int tidx = TIDX(swave);
  const float* lam_re = INP(p, 14) + (size_t)j * 2 * 16 * 64;
  const float* lam_im = INP(p, 15) + (size_t)j * 2 * 16 * 64;
  const float* log_dt = INP(p, 16) + (size_t)j * 2 * 16;
  const float* b_re = INP(p, 17) + (size_t)j * 16 * 64 * 16;
  const float* b_im = INP(p, 18) + (size_t)j * 16 * 64 * 16;
  const float* c_re = INP(p, 19) + (size_t)j * 16 * 16 * 64;
  const float* c_im = INP(p, 20) + (size_t)j * 16 * 16 * 64;
  bf16_t* TRt = (bf16_t*)(WS(p) + OFF_S5M);
  bf16_t* Pm = (bf16_t*)(WS(p) + OFF_S5M + S5M_PM);
  const int gtid = bidx * 512 + tidx, gsz = nblk * 512;
  for (int it = gtid; it < 16 * 2 * 64 * 64; it += gsz) {
    const int n = it & 63, t = (it >> 6) & 63, dir = (it >> 12) & 1, g = it >> 13;
    const float lr = fminf(lam_re[(dir * 16 + g) * 64 + n], -1e-4f), li = lam_im[(dir * 16 + g) * 64 + n];
    const float dt = __expf(log_dt[dir * 16 + g]);
    const int dist = dir == 0 ? (t + 1) : (64 - t);
    float cs, sn; cis_d((double)li * (double)dt * (double)dist, cs, sn);
    const float mag = __expf(lr * dt * (float)dist);
    const float er = mag * cs, ei = mag * sn;
#pragma unroll 4
    for (int pp = 0; pp < 16; ++pp) {
      const float cr = c_re[(g * 16 + pp) * 64 + n], ci = c_im[(g * 16 + pp) * 64 + n];
      const float Er = cr * er - ci * ei, Ei = cr * ei + ci * er;
      *(unsigned*)(TRt + ((size_t)g * 1024 + t * 16 + pp) * 1280 + 1024 + dir * 128 + n * 2) = pk2(Er, -Ei);
    }
  }
  for (int it = gtid; it < 16 * 2 * 64 * 64; it += gsz) {
    const int t = it & 63, n = (it >> 6) & 63, dir = (it >> 12) & 1, g = it >> 13;
    const float lr = fminf(lam_re[(dir * 16 + g) * 64 + n], -1e-4f), li = lam_im[(dir * 16 + g) * 64 + n];
    const float dt = __expf(log_dt[dir * 16 + g]);
    float c1, s1; cis_d((double)li * (double)dt, c1, s1);
    const float m1 = __expf(lr * dt);
    const float ar = m1 * c1, ai = m1 * s1;
    const float den = lr * lr + li * li, nr = ar - 1.f;
    const float cr = (nr * lr + ai * li) / den, ci = (ai * lr - nr * li) / den;
    const int e = dir == 0 ? (63 - t) : t;
    float ce, se; cis_d((double)li * (double)dt * (double)e, ce, se);
    const float me = __expf(lr * dt * (float)e);
    const float pr = me * ce, pi = me * se;
    const float wr_ = pr * cr - pi * ci, wi_ = pr * ci + pi * cr;
    unsigned ore[8], oim[8];
#pragma unroll
    for (int pp = 0; pp < 16; pp += 2) {
      const float br0 = b_re[(g * 64 + n) * 16 + pp], bi0 = b_im[(g * 64 + n) * 16 + pp];
      const float br1 = b_re[(g * 64 + n) * 16 + pp + 1], bi1 = b_im[(g * 64 + n) * 16 + pp + 1];
      ore[pp >> 1] = pk2(wr_ * br0 - wi_ * bi0, wr_ * br1 - wi_ * bi1);
      oim[pp >> 1] = pk2(wr_ * bi0 + wi_ * br0, wr_ * bi1 + wi_ * br1);
    }
    uint4* rowre = (uint4*)(Pm + ((size_t)g * 256 + dir * 128 + n * 2 + 0) * 1024 + t * 16);
    uint4* rowim = (uint4*)(Pm + ((size_t)g * 256 + dir * 128 + n * 2 + 1) * 1024 + t * 16);
    rowre[0] = make_uint4(ore[0], ore[1], ore[2], ore[3]); rowre[1] = make_uint4(ore[4], ore[5], ore[6], ore[7]);
    rowim[0] = make_uint4(oim[0], oim[1], oim[2], oim[3]); rowim[1] = make_uint4(oim[4], oim[5], oim[6], oim[7]);
  }
}

__device__ void s5_ktab(int swave, const Params& p, int j, char* shm, int bidx, int nblk) {
  const int tidx = TIDX(swave);
  const float* lam_re = INP(p, 14) + (size_t)j * 2 * 16 * 64;
  const float* lam_im = INP(p, 15) + (size_t)j * 2 * 16 * 64;
  const float* log_dt = INP(p, 16) + (size_t)j * 2 * 16;
  const float* b_re = INP(p, 17) + (size_t)j * 16 * 64 * 16;
  const float* b_im = INP(p, 18) + (size_t)j * 16 * 64 * 16;
  const float* c_re = INP(p, 19) + (size_t)j * 16 * 16 * 64;
  const float* c_im = INP(p, 20) + (size_t)j * 16 * 16 * 64;
  const float* dsk = INP(p, 21) + (size_t)j * 256;
  float* Ktab = (float*)(WS(p) + OFF_MISC);
  float* wre = (float*)shm;
  float* wim = wre + 2 * 64 * 16;
  const int tid = tidx;
  for (int unit = bidx; unit < 16 * 127; unit += nblk) {
    const int g = unit / 127, delta = unit % 127;
    const int tau = delta >= 63 ? delta - 63 : 63 - delta;
    __syncthreads();
    for (int e = tid; e < 2 * 64 * 16; e += 512) {
      const int pp = e & 15, n = (e >> 4) & 63, dir = e >> 10;
      const float lr = fminf(lam_re[(dir * 16 + g) * 64 + n], -1e-4f), li = lam_im[(dir * 16 + g) * 64 + n];
      const float dt = __expf(log_dt[dir * 16 + g]);
      float c1, s1; cis_d((double)li * (double)dt, c1, s1);
      const float m1 = __expf(lr * dt);
      const float ar = m1 * c1, ai = m1 * s1;
      const float den = lr * lr + li * li, nr = ar - 1.f;
      const float cr = (nr * lr + ai * li) / den, ci = (ai * lr - nr * li) / den;
      float ce, se; cis_d((double)li * (double)dt * (double)tau, ce, se);
      const float me = __expf(lr * dt * (float)tau);
      const float pr = me * ce, pi = me * se;
      const float wr_ = pr * cr - pi * ci, wi_ = pr * ci + pi * cr;
      const float br = b_re[(g * 64 + n) * 16 + pp], bi = b_im[(g * 64 + n) * 16 + pp];
      wre[e] = wr_ * br - wi_ * bi; wim[e] = wr_ * bi + wi_ * br;
    }
    __syncthreads();
    if (tid < 256) {
      const int pq = tid >> 4, pp = tid & 15;
      float accv = 0.f;
      const int d0 = delta > 63 ? 0 : (delta < 63 ? 1 : 0), d1 = delta == 63 ? 1 : d0;
      for (int dir = d0; dir <= d1; ++dir)
        for (int n = 0; n < 64; ++n) {
          const float cr = c_re[(g * 16 + pq) * 64 + n], ci = c_im[(g * 16 + pq) * 64 + n];
          accv += cr * wre[(dir * 64 + n) * 16 + pp] - ci * wim[(dir * 64 + n) * 16 + pp];
        }
      if (delta == 63 && pq == pp) accv += dsk[g * 16 + pq];
      Ktab[((size_t)g * 127 + delta) * 256 + pq * 16 + pp] = accv;
    }
  }
  __syncthreads();
}

__device__ void prep_phase(int swave, const Params& p, int layer, char* shm) {
  const int tidx = TIDX(swave);
  const int bidx = BIDX();
  const int j = layer >> 1;
  const bool odd = layer & 1;
  bf16_t* WB = (bf16_t*)(WS(p) + OFF_WB);
  int job = 0;
  if (!odd) {
    job = transpose_tiles(swave, INP(p, 4) + (size_t)j * 1024 * 3360, 3360, 1024, 3360, WB + WB_IN, 1024, shm, job);
    job = transpose_tiles(swave, INP(p, 5) + (size_t)j * 1024 * 1024, 1024, 1024, 1024, WB + WB_OUT, 1024, shm, job);
  } else {
    job = transpose_tiles(swave, INP(p, 11) + (size_t)j * 1024 * 2816, 2816, 1024, 2816, WB + WB_IN, 1024, shm, job);
    job = transpose_tiles(swave, INP(p, 12) + (size_t)j * 1024 * 1024, 1024, 1024, 1024, WB + WB_OUT, 1024, shm, job);
    job = transpose_tiles(swave, INP(p, 22) + (size_t)j * 256 * 256, 256, 256, 256, WB + WB_GLU, 256, shm, job);
  }
  const float* wup = INP(p, 24) + (size_t)layer * 1024 * 5632;
  const float* wdn = INP(p, 27) + (size_t)layer * 2816 * 1024;
  job = transpose_tiles(swave, wdn, 1024, FFN, 1024, WB + WB_DOWN, FFN, shm, job);
  for (int h = 0; h < 2; ++h) {
    const int c0 = ffn_c0(h), nh = ffn_n(h);
    bf16_t* up = WB + WB_UP + (size_t)2 * c0 * 1024;
    job = transpose_tiles(swave, wup + c0, 5632, 1024, nh, up, 1024, shm, job);
    job = transpose_tiles(swave, wup + FFN + c0, 5632, 1024, nh, up + (size_t)nh * 1024, 1024, shm, job);
  }
  if (layer == 0) rmsnorm_rows_bf16(swave, INP(p, 0), nullptr, nullptr, INP(p, 1), (bf16_t*)(WS(p) + OFF_A16));
  else { float* o = OUTP(p); rmsnorm_rows_bf16(swave, o, (const bf16_t*)(WS(p) + OFF_PU), o, INP(p, 1) + (size_t)layer * DM, (bf16_t*)(WS(p) + OFF_A16)); }
  if (layer == 1) { s5_tables(swave, p, j, BIDX(), gridDim.x); s5_ktab(swave, p, j, shm, BIDX(), gridDim.x); }
  if (layer == 0) {
    float2* rope = (float2*)(WS(p) + OFF_MISC + MISC_ROPE);
    for (int it = bidx * 512 + tidx; it < SEQ * 64; it += gridDim.x * 512) {
      const int i = it & 63, pos = it >> 6;
      const double inv = (double)exp2f(-(float)i * (13.287712379549449f / 64.0f));
      float c, s; cis_d((double)pos * inv, c, s);
      rope[it] = make_float2(c, s);
    }
  }
}

template <int MODE>
__device__ void scan_unit(int swave, const Params& p, int j, int b, int h, int dir, char* shm) {
  const int tidx = TIDX(swave);
  constexpr int DK = MODE == 2 ? 128 : 64, DV = MODE == 2 ? 192 : 128, KS = DK / 64, NVT = (DV / 16) / (8 / KS);
  constexpr int QS = DK + 8, VS = 20, OS = DV + 4;
  constexpr int OFF_KT = 16 * QS * 2, OFF_KO = OFF_KT + 16 * QS * 2, OFF_VT = OFF_KO + DK * 32, OFF_DEC = OFF_VT + DV * VS * 2, BUFB = OFF_DEC + DK * 4;
  constexpr int LDP = MODE == 2 ? ODD_IN : EVEN_INP;
  constexpr int OLD = MODE == 2 ? 768 : 1024;
  char* buf0 = shm;

  bf16_t* obuf0 = (bf16_t*)(shm + 4 * BUFB);
  const bf16_t* P = (const bf16_t*)(WS(p) + OFF_PU);
  const int tid = tidx, lane = tid & 63, w = tid >> 6, r = lane & 15, q4 = lane >> 4;
  const int wk = w % KS, wv = w / KS, slab = wk * 64, vt0 = wv * NVT;
  const int hh = MODE == 1 ? 4 + h : h;
  bf16_t* O = (bf16_t*)(WS(p) + OFF_OFB + (dir ? (MODE == 2 ? OFB_OB_ODD : OFB_OB_EVEN) : 0)) + hh * DV;
  const size_t rowbase = (size_t)b * SEQ;
  const int ti = lane & 15, dp = (tid >> 4) * 2;
  float wa2r[32]; float bav0 = 0.f, bav1 = 0.f, lbv0 = 0.f, lbv1 = 0.f, lg = 0.f;
  const float2* rope = (const float2*)(WS(p) + OFF_MISC + MISC_ROPE);
  if (MODE == 0) {
    const float* wa2 = INP(p, 6) + ((size_t)(j * 2 + dir) * 16) * 256 + h * 64 + dp;
#pragma unroll
    for (int rr = 0; rr < 16; ++rr) { const float2 t2 = *(const float2*)(wa2 + rr * 256); wa2r[2 * rr] = t2.x; wa2r[2 * rr + 1] = t2.y; }
    const float2 bb = *(const float2*)(INP(p, 7) + (j * 2 + dir) * 256 + h * 64 + dp);
    bav0 = bb.x; bav1 = bb.y;
  } else if (MODE == 1) {
    if (j > 0) {
      const float2 l0 = *(const float2*)(INP(p, 9) + (dir * 2 + 0) * 256 + h * 64 + dp), l1 = *(const float2*)(INP(p, 9) + (dir * 2 + 1) * 256 + h * 64 + dp);
      lbv0 = 1.f / (1.f + __expf(l0.x - l1.x)); lbv1 = 1.f / (1.f + __expf(l0.y - l1.y));
    }
  } else {
    lg = log1pf(-exp2f((dir ? -5.5f : -5.0f) - (float)h));
  }
  const int vg = tid >> 4;
  const float ret_ein = __expf(lg * (float)(ti + 1)), ret_eti = __expf(-lg * (float)(ti + 1)), ret_eout = __expf(lg * (float)(15 - ti)), ret_dd = __expf(lg * 16.f);
  struct Raw { unsigned q, k, q2, k2; uint4 lr0, lr1; uint2 v; unsigned v30, v31, v32; float4 cs; };
  auto tokof = [&](int c, int i) { int t = c * 16 + i; return dir ? (SEQ - 1 - t) : t; };
  auto load_raw = [&](int c, Raw& R) {
    const int tok = tokof(c, ti);
    const bf16_t* row = P + (rowbase + tok) * LDP;
    if (MODE == 0) {
      R.q = *(const unsigned*)(row + E_GQ + h * 64 + dp); R.k = *(const unsigned*)(row + E_GK + h * 64 + dp);
      const uint4* lrp = (const uint4*)(row + (dir ? E_GLB : E_GLF));
      R.lr0 = lrp[0]; R.lr1 = lrp[1];
      R.v = *(const uint2*)(row + E_GV + h * 128 + vg * 4);
    } else if (MODE == 1) {
      R.q = *(const unsigned*)(row + E_HQ + h * 64 + dp); R.k = *(const unsigned*)(row + (dir ? E_HZB : E_HZF) + h * 64 + dp);
      R.v = *(const uint2*)(row + E_HI + h * 128 + vg * 4);
    } else {
      R.q = *(const unsigned*)(row + O_RQ + h * 128 + dp); R.q2 = *(const unsigned*)(row + O_RQ + h * 128 + 64 + dp);
      R.k = *(const unsigned*)(row + O_RK + h * 128 + dp); R.k2 = *(const unsigned*)(row + O_RK + h * 128 + 64 + dp);
      R.cs = *(const float4*)(rope + tok * 64 + dp);
      const unsigned* vp = (const unsigned*)(row + O_RV + h * 192 + vg * 6);
      R.v30 = vp[0]; R.v31 = vp[1]; R.v32 = vp[2];
    }
  };
  auto row_scan = [&](float x, float& total) {
    x += __int_as_float(__builtin_amdgcn_update_dpp(0, __float_as_int(x), 0x111, 0xf, 0xf, true));
    x += __int_as_float(__builtin_amdgcn_update_dpp(0, __float_as_int(x), 0x112, 0xf, 0xf, true));
    x += __int_as_float(__builtin_amdgcn_update_dpp(0, __float_as_int(x), 0x114, 0xf, 0xf, true));
    x += __int_as_float(__builtin_amdgcn_update_dpp(0, __float_as_int(x), 0x118, 0xf, 0xf, true));
    total = __int_as_float(__builtin_amdgcn_ds_bpermute((lane | 15) << 2, __float_as_int(x)));
    return x;
  };
  auto stage2 = [&](const Raw& R, char* buf, int c) {
    bf16_t* qin = (bf16_t*)buf; bf16_t* ktil = (bf16_t*)(buf + OFF_KT); bf16_t* koutT = (bf16_t*)(buf + OFF_KO);
    bf16_t* vT = (bf16_t*)(buf + OFF_VT); float* dec = (float*)(buf + OFF_DEC);
    if (MODE != 2) {
      float g0, g1;
      if (MODE == 0) {
        float z0 = bav0, z1 = bav1;
        const unsigned lw[8] = {R.lr0.x, R.lr0.y, R.lr0.z, R.lr0.w, R.lr1.x, R.lr1.y, R.lr1.z, R.lr1.w};
#pragma unroll
        for (int e = 0; e < 8; ++e) {
          const float a0 = lo_bf(lw[e]), a1 = hi_bf(lw[e]);
          z0 += a0 * wa2r[4 * e] + a1 * wa2r[4 * e + 2];
          z1 += a0 * wa2r[4 * e + 1] + a1 * wa2r[4 * e + 3];
        }
        g0 = (fminf(z0, 0.f) - __logf(1.f + __expf(-fabsf(z0)))) * (1.f / 16.f);
        g1 = (fminf(z1, 0.f) - __logf(1.f + __expf(-fabsf(z1)))) * (1.f / 16.f);
      } else {
        const float f0 = lbv0 + (1.f - lbv0) * sigmoidf_(lo_bf(R.k)), f1 = lbv1 + (1.f - lbv1) * sigmoidf_(hi_bf(R.k));
        g0 = __logf(fmaxf(f0, 1e-20f)); g1 = __logf(fmaxf(f1, 1e-20f));
      }
      float s0, s1;
      const float cum0 = row_scan(g0, s0), cum1 = row_scan(g1, s1);
      float q0, q1, k0, k1;
      if (MODE == 0) { q0 = lo_bf(R.q); q1 = hi_bf(R.q); k0 = lo_bf(R.k) * 0.125f; k1 = hi_bf(R.k) * 0.125f; }
      else { q0 = siluf_(lo_bf(R.q)); q1 = siluf_(hi_bf(R.q)); k0 = (1.f - lbv0) * sigmoidf_(-lo_bf(R.k)); k1 = (1.f - lbv1) * sigmoidf_(-hi_bf(R.k)); }
      *(unsigned*)(qin + ti * QS + dp) = pk2(q0 * __expf(cum0), q1 * __expf(cum1));
      *(unsigned*)(ktil + ti * QS + dp) = pk2(k0 * __expf(-cum0), k1 * __expf(-cum1));
      koutT[dp * 16 + ti] = f2bf(k0 * __expf(s0 - cum0));
      koutT[(dp + 1) * 16 + ti] = f2bf(k1 * __expf(s1 - cum1));
      if (ti == 0) *(float2*)(dec + dp) = make_float2(__expf(s0), __expf(s1));
      const unsigned v0 = R.v.x, v1 = R.v.y; const int c4 = vg * 4;
      vT[(c4 + 0) * VS + ti] = (bf16_t)(v0 & 0xffff); vT[(c4 + 1) * VS + ti] = (bf16_t)(v0 >> 16);
      vT[(c4 + 2) * VS + ti] = (bf16_t)(v1 & 0xffff); vT[(c4 + 3) * VS + ti] = (bf16_t)(v1 >> 16);
    } else {
      const float KSC = 0.08838834764831845f;
      const float qx0 = lo_bf(R.q), qx1 = hi_bf(R.q), qy0 = lo_bf(R.q2), qy1 = hi_bf(R.q2);
      const float kx0 = lo_bf(R.k) * KSC, kx1 = hi_bf(R.k) * KSC, ky0 = lo_bf(R.k2) * KSC, ky1 = hi_bf(R.k2) * KSC;
      const float c0 = R.cs.x, sn0 = R.cs.y, c1 = R.cs.z, sn1 = R.cs.w;
      const float qa0 = qx0 * c0 - qy0 * sn0, qb0 = qx0 * sn0 + qy0 * c0, qa1 = qx1 * c1 - qy1 * sn1, qb1 = qx1 * sn1 + qy1 * c1;
      const float ka0 = kx0 * c0 - ky0 * sn0, kb0 = kx0 * sn0 + ky0 * c0, ka1 = kx1 * c1 - ky1 * sn1, kb1 = kx1 * sn1 + ky1 * c1;
      const float ein = ret_ein, eti = ret_eti, eout = ret_eout;
      *(unsigned*)(qin + ti * QS + dp) = pk2(qa0 * ein, qa1 * ein); *(unsigned*)(qin + ti * QS + 64 + dp) = pk2(qb0 * ein, qb1 * ein);
      *(unsigned*)(ktil + ti * QS + dp) = pk2(ka0 * eti, ka1 * eti); *(unsigned*)(ktil + ti * QS + 64 + dp) = pk2(kb0 * eti, kb1 * eti);
      koutT[dp * 16 + ti] = f2bf(ka0 * eout); koutT[(dp + 1) * 16 + ti] = f2bf(ka1 * eout);
      koutT[(64 + dp) * 16 + ti] = f2bf(kb0 * eout); koutT[(65 + dp) * 16 + ti] = f2bf(kb1 * eout);
      if (ti == 0) { const float dd = ret_dd; *(float2*)(dec + dp) = make_float2(dd, dd); *(float2*)(dec + 64 + dp) = make_float2(dd, dd); }
      const int c6 = vg * 6;
      vT[(c6 + 0) * VS + ti] = (bf16_t)(R.v30 & 0xffff); vT[(c6 + 1) * VS + ti] = (bf16_t)(R.v30 >> 16);
      vT[(c6 + 2) * VS + ti] = (bf16_t)(R.v31 & 0xffff); vT[(c6 + 3) * VS + ti] = (bf16_t)(R.v31 >> 16);
      vT[(c6 + 4) * VS + ti] = (bf16_t)(R.v32 & 0xffff); vT[(c6 + 5) * VS + ti] = (bf16_t)(R.v32 >> 16);
    }
  };
  f32x4 S[4][NVT];
#pragma unroll
  for (int a = 0; a < 4; ++a)
#pragma unroll
    for (int t = 0; t < NVT; ++t) S[a][t] = (f32x4){0.f, 0.f, 0.f, 0.f};
  auto compute = [&](const char* buf, bf16_t* obuf) {
    const bf16_t* qin = (const bf16_t*)buf; const bf16_t* ktil = (const bf16_t*)(buf + OFF_KT); const bf16_t* koutT = (const bf16_t*)(buf + OFF_KO);
    const bf16_t* vT = (const bf16_t*)(buf + OFF_VT); const float* dec = (const float*)(buf + OFF_DEC);
    bf16x8 Asc = {0, 0, 0, 0, 0, 0, 0, 0};
    if (KS == 1 || wk == 0) {
      f32x4 sc = {0.f, 0.f, 0.f, 0.f};
#pragma unroll
      for (int m = 0; m < DK / 32; ++m) {
        const bf16x8 a = *(const bf16x8*)(ktil + r * QS + m * 32 + q4 * 8);
        const bf16x8 bb = *(const bf16x8*)(qin + r * QS + m * 32 + q4 * 8);
        sc = __builtin_amdgcn_mfma_f32_16x16x32_bf16(a, bb, sc, 0, 0, 0);
      }
      {
        const unsigned p01 = pk2(q4 * 4 + 0 > r ? 0.f : sc[0], q4 * 4 + 1 > r ? 0.f : sc[1]);
        const unsigned p23 = pk2(q4 * 4 + 2 > r ? 0.f : sc[2], q4 * 4 + 3 > r ? 0.f : sc[3]);
        Asc[0] = (short)(p01 & 0xffff); Asc[1] = (short)(p01 >> 16); Asc[2] = (short)(p23 & 0xffff); Asc[3] = (short)(p23 >> 16);
      }
    }
    bf16x8 Bv[NVT];
#pragma unroll
    for (int t = 0; t < NVT; ++t) {
      const uint2 vv = *(const uint2*)(vT + ((vt0 + t) * 16 + r) * VS + q4 * 4);
      Bv[t] = (bf16x8){(short)(vv.x & 0xffff), (short)(vv.x >> 16), (short)(vv.y & 0xffff), (short)(vv.y >> 16), 0, 0, 0, 0};
    }
    bf16x8 Aq[2];
#pragma unroll
    for (int m = 0; m < 2; ++m) {
      const uint2 lo = *(const uint2*)(qin + r * QS + slab + (2 * m) * 16 + q4 * 4);
      const uint2 hi = *(const uint2*)(qin + r * QS + slab + (2 * m + 1) * 16 + q4 * 4);
      Aq[m] = (bf16x8){(short)(lo.x & 0xffff), (short)(lo.x >> 16), (short)(lo.y & 0xffff), (short)(lo.y >> 16),
                       (short)(hi.x & 0xffff), (short)(hi.x >> 16), (short)(hi.y & 0xffff), (short)(hi.y >> 16)};
    }
    f32x4 o[NVT];
#pragma unroll
    for (int t = 0; t < NVT; ++t) {
      o[t] = (f32x4){0.f, 0.f, 0.f, 0.f};
      if (KS == 1 || wk == 0) o[t] = __builtin_amdgcn_mfma_f32_16x16x32_bf16(Asc, Bv[t], o[t], 0, 0, 0);
    }
#pragma unroll
    for (int m = 0; m < 2; ++m)
#pragma unroll
      for (int t = 0; t < NVT; ++t) {
        const f32x4 s0 = S[2 * m][t], s1 = S[2 * m + 1][t];
        union { unsigned u[4]; bf16x8 v; } cv;
        cv.u[0] = pk2(s0[0], s0[1]); cv.u[1] = pk2(s0[2], s0[3]); cv.u[2] = pk2(s1[0], s1[1]); cv.u[3] = pk2(s1[2], s1[3]);
        o[t] = __builtin_amdgcn_mfma_f32_16x16x32_bf16(Aq[m], cv.v, o[t], 0, 0, 0);
      }
#pragma unroll
    for (int t = 0; t < NVT; ++t)
#pragma unroll
      for (int jj = 0; jj < 4; ++jj) obuf[(wk * 16 + q4 * 4 + jj) * OS + (vt0 + t) * 16 + r] = f2bf(o[t][jj]);
#pragma unroll
    for (int kt = 0; kt < 4; ++kt) {
      const uint2 kk = *(const uint2*)(koutT + (slab + kt * 16 + r) * 16 + q4 * 4);
      const bf16x8 Ak = {(short)(kk.x & 0xffff), (short)(kk.x >> 16), (short)(kk.y & 0xffff), (short)(kk.y >> 16), 0, 0, 0, 0};
      const f32x4 dc = *(const f32x4*)(dec + slab + kt * 16 + q4 * 4);
#pragma unroll
      for (int t = 0; t < NVT; ++t) S[kt][t] = __builtin_amdgcn_mfma_f32_16x16x32_bf16(Ak, Bv[t], S[kt][t] * dc, 0, 0, 0);
    }
  };
  auto ostore = [&](int c, const bf16_t* obuf) {
    for (int idx = tid; idx < 16 * DV / 4; idx += 512) {
      const int i = idx / (DV / 4), cc = (idx % (DV / 4)) * 4;
      uint2 o = *(const uint2*)(obuf + i * OS + cc);
      if (KS == 2) {
        const uint2 o2 = *(const uint2*)(obuf + (16 + i) * OS + cc);
        o.x = pk2(lo_bf(o.x) + lo_bf(o2.x), hi_bf(o.x) + hi_bf(o2.x)); o.y = pk2(lo_bf(o.y) + lo_bf(o2.y), hi_bf(o.y) + hi_bf(o2.y));
      }
      *(uint2*)(O + (rowbase + tokof(c, i)) * OLD + cc) = o;
    }
  };
  constexpr int NCH = SEQ / 16;
  auto touch = [&](Raw& R) {
    if (MODE == 0) {
      asm volatile("" :: "v"(R.q), "v"(R.k), "v"(R.v.x), "v"(R.v.y), "v"(R.lr0.x), "v"(R.lr0.y), "v"(R.lr0.z), "v"(R.lr0.w), "v"(R.lr1.x), "v"(R.lr1.y), "v"(R.lr1.z), "v"(R.lr1.w) : "memory");
    } else if (MODE == 1) {
      asm volatile("" :: "v"(R.q), "v"(R.k), "v"(R.v.x), "v"(R.v.y) : "memory");
    } else {
      asm volatile("" :: "v"(R.q), "v"(R.k), "v"(R.q2), "v"(R.k2), "v"(R.cs.x), "v"(R.cs.y), "v"(R.cs.z), "v"(R.cs.w), "v"(R.v30), "v"(R.v31), "v"(R.v32) : "memory");
    }
  };
  constexpr int NIT = NCH / 2, OB1 = KS * 16 * OS;
  auto bufp = [&](int stage, int sub) { return buf0 + (stage * 2 + sub) * BUFB; };
  auto obp = [&](int stage, int sub) { return obuf0 + (stage * 2 + sub) * OB1; };
  Raw a0, a1, b0, b1;
  __syncthreads();
  load_raw(0, a0); load_raw(1, a1);
  stage2(a0, bufp(0, 0), 0); stage2(a1, bufp(0, 1), 1);
  load_raw(2, a0); load_raw(3, a1);
  lds_barrier();
  auto body = [&](int it, Raw& c0, Raw& c1, Raw& n0, Raw& n1) {
    touch(c0); touch(c1);
    __builtin_amdgcn_sched_barrier(0);
    const int cA = 2 * it + 4 < NCH ? 2 * it + 4 : NCH - 2;
    load_raw(cA, n0); load_raw(cA + 1, n1);
    if (it > 0) { ostore(2 * it - 2, obp((it - 1) & 1, 0)); ostore(2 * it - 1, obp((it - 1) & 1, 1)); }
    stage2(c0, bufp((it + 1) & 1, 0), 0); stage2(c1, bufp((it + 1) & 1, 1), 0);
    compute(bufp(it & 1, 0), obp(it & 1, 0)); compute(bufp(it & 1, 1), obp(it & 1, 1));
    lds_barrier();
  };
  for (int it = 0; it < NIT; it += 2) { body(it, a0, a1, b0, b1); body(it + 1, b0, b1, a0, a1); }
  ostore(NCH - 2, obp((NIT - 1) & 1, 0)); ostore(NCH - 1, obp((NIT - 1) & 1, 1));
  __syncthreads();
}

__device__ void scan_even_phase(int swave, const Params& p, int j, char* shm) {
  const int bidx = BIDX();
  for (int unit = bidx; unit < 256; unit += gridDim.x) {
    const int dir = unit & 1, hh = (unit >> 1) & 7, b = unit >> 4;
    if (hh < 4) scan_unit<0>(swave, p, j, b, hh, dir, shm); else scan_unit<1>(swave, p, j, b, hh - 4, dir, shm);
  }
}

__device__ void s5_fill(int swave, const Params& p, int vb, int nvb) {
  const int tidx = TIDX(swave);
  const bf16_t* P = (const bf16_t*)(WS(p) + OFF_PU);
  bf16_t* U2 = (bf16_t*)(WS(p) + OFF_OFB + OFB_U2);
  bf16_t* TRt = (bf16_t*)(WS(p) + OFF_S5M);
  const float* Ktab = (const float*)(WS(p) + OFF_MISC);
  const int gtid = vb * 512 + tidx, gsz = nvb * 512;
  for (int it = gtid; it < TOK * 16; it += gsz) {
    const int g = it & 15, token = it >> 4;
    const uint4* s = (const uint4*)(P + (size_t)token * ODD_IN + O_SU + g * 16);
    uint4* d = (uint4*)(U2 + ((size_t)g * 512 + (token >> 6)) * 1280 + (token & 63) * 16);
    d[0] = s[0]; d[1] = s[1];
  }
  for (int it = gtid; it < 16 * 1024 * 128; it += gsz) {
    const int half = it & 1, jj = (it >> 1) & 63, pp = (it >> 7) & 15, t = (it >> 11) & 63, g = it >> 17;
    const float4* s = (const float4*)(Ktab + ((size_t)g * 127 + (t - jj + 63)) * 256 + pp * 16 + half * 8);
    const float4 a = s[0], bq = s[1];
    uint4 o; o.x = pk2(a.x, a.y); o.y = pk2(a.z, a.w); o.z = pk2(bq.x, bq.y); o.w = pk2(bq.z, bq.w);
    *(uint4*)(TRt + ((size_t)g * 1024 + t * 16 + pp) * 1280 + jj * 16 + half * 8) = o;
  }
}

__device__ __forceinline__ float row16_allsum(float x) {
  x += __int_as_float(__builtin_amdgcn_update_dpp(0, __float_as_int(x), 0x128, 0xf, 0xf, true));
  x += __int_as_float(__builtin_amdgcn_update_dpp(0, __float_as_int(x), 0x124, 0xf, 0xf, true));
  x += __int_as_float(__builtin_amdgcn_update_dpp(0, __float_as_int(x), 0x122, 0xf, 0xf, true));
  x += __int_as_float(__builtin_amdgcn_update_dpp(0, __float_as_int(x), 0x121, 0xf, 0xf, true));
  return x;
}
__device__ void post_even_phase(int swave, const Params& p, int j) {
  const int tidx = TIDX(swave);
  const int bidx = BIDX();
  const bf16_t* P = (const bf16_t*)(WS(p) + OFF_PU);
  const bf16_t* OF = (const bf16_t*)(WS(p) + OFF_OFB);
  const bf16_t* OB = (const bf16_t*)(WS(p) + OFF_OFB + OFB_OB_EVEN);
  bf16_t* Y = (bf16_t*)(WS(p) + OFF_A16);
  const float* gla_g = INP(p, 8) + (size_t)j * 512;
  const float* hgrn_g = INP(p, 10) + (size_t)j * 512;
  const int l16 = tidx & 15;
  for (int it = bidx * 32 + (tidx >> 4); it < TOK * 8; it += gridDim.x * 32) {
    const int hh = it & 7, token = it >> 3;
    const size_t oidx = (size_t)token * 1024 + hh * 128 + l16 * 8;
    const uint4 a = ld_nt16(OF + oidx), bq = ld_nt16(OB + oidx);
    const int gcol = (hh < 4 ? E_GR + hh * 128 : E_HG + (hh - 4) * 128) + l16 * 8;
    const uint4 gt = ld_nt16(P + (size_t)token * EVEN_INP + gcol);
    const float* gn = (hh < 4 ? gla_g + hh * 128 : hgrn_g + (hh - 4) * 128) + l16 * 8;
    const float4 gn0 = *(const float4*)gn, gn1 = *(const float4*)(gn + 4);
    const unsigned av[4] = {a.x, a.y, a.z, a.w}, bv[4] = {bq.x, bq.y, bq.z, bq.w}, gv[4] = {gt.x, gt.y, gt.z, gt.w};
    const float gnv[8] = {gn0.x, gn0.y, gn0.z, gn0.w, gn1.x, gn1.y, gn1.z, gn1.w};
    float o[8]; float ss = 0.f;
#pragma unroll
    for (int e = 0; e < 4; ++e) { o[2 * e] = lo_bf(av[e]) + lo_bf(bv[e]); o[2 * e + 1] = hi_bf(av[e]) + hi_bf(bv[e]); ss += o[2 * e] * o[2 * e] + o[2 * e + 1] * o[2 * e + 1]; }
    ss = row16_allsum(ss);
    const float rs = rsqrtf(ss * (1.f / 128.f) + EPS);
    unsigned ov[4];
#pragma unroll
    for (int e = 0; e < 4; ++e)
      ov[e] = pk2(o[2 * e] * rs * gnv[2 * e] * siluf_(lo_bf(gv[e])), o[2 * e + 1] * rs * gnv[2 * e + 1] * siluf_(hi_bf(gv[e])));
    *(uint4*)(Y + oidx) = make_uint4(ov[0], ov[1], ov[2], ov[3]);
  }
}
__device__ void post_odd_phase(int swave, const Params& p, int j) {
  const int tidx = TIDX(swave);
  const int bidx = BIDX();
  const bf16_t* P = (const bf16_t*)(WS(p) + OFF_PU);
  const bf16_t* OF = (const bf16_t*)(WS(p) + OFF_OFB);
  const bf16_t* OB = (const bf16_t*)(WS(p) + OFF_OFB + OFB_OB_ODD);
  bf16_t* Y = (bf16_t*)(WS(p) + OFF_A16);
  const float* gn = INP(p, 13) + (size_t)j * 768;
  const int l16 = tidx & 15;
  for (int it = bidx * 32 + (tidx >> 4); it < TOK * 4; it += gridDim.x * 32) {
    const int h = it & 3, token = it >> 2;
    float o[12]; float sm = 0.f;
#pragma unroll
    for (int e = 0; e < 3; ++e) {
      const size_t oidx = (size_t)token * 768 + h * 192 + e * 64 + l16 * 4;
      const uint2 a = ld_nt8(OF + oidx), bq = ld_nt8(OB + oidx);
      o[4 * e] = lo_bf(a.x) + lo_bf(bq.x); o[4 * e + 1] = hi_bf(a.x) + hi_bf(bq.x); o[4 * e + 2] = lo_bf(a.y) + lo_bf(bq.y); o[4 * e + 3] = hi_bf(a.y) + hi_bf(bq.y);
      sm += o[4 * e] + o[4 * e + 1] + o[4 * e + 2] + o[4 * e + 3];
    }
    const float mu = row16_allsum(sm) * (1.f / 192.f);
    float vs = 0.f;
#pragma unroll
    for (int e = 0; e < 12; ++e) { o[e] -= mu; vs += o[e] * o[e]; }
    const float rs = rsqrtf(row16_allsum(vs) * (1.f / 192.f) + EPS);
#pragma unroll
    for (int e = 0; e < 3; ++e) {
      const int c = h * 192 + e * 64 + l16 * 4;
      const uint2 gt = ld_nt8(P + (size_t)token * ODD_IN + O_RG + c);
      const float4 g4 = *(const float4*)(gn + c);
      uint2 ov;
      ov.x = pk2(o[4 * e] * rs * g4.x * siluf_(lo_bf(gt.x)), o[4 * e + 1] * rs * g4.y * siluf_(hi_bf(gt.x)));
      ov.y = pk2(o[4 * e + 2] * rs * g4.z * siluf_(lo_bf(gt.y)), o[4 * e + 3] * rs * g4.w * siluf_(hi_bf(gt.y)));
      *(uint2*)(Y + (size_t)token * DM + c) = ov;
    }
  }
}

__device__ void s5_scan_phase(int swave, const Params& p, int j, int vb, int nv) {
  const int tidx = TIDX(swave);
  const float* lam_re = INP(p, 14) + (size_t)j * 2 * 16 * 64;
  const float* lam_im = INP(p, 15) + (size_t)j * 2 * 16 * 64;
  const float* log_dt = INP(p, 16) + (size_t)j * 2 * 16;
  const float* Dst = (const float*)(WS(p) + OFF_OFB + OFB_DST);
  bf16_t* U2 = (bf16_t*)(WS(p) + OFF_OFB + OFB_U2);
  for (int it = vb * 512 + tidx; it < NBATCH * 16 * 2 * 64; it += nv * 512) {
    const int n = it & 63, dir = (it >> 6) & 1, g = (it >> 7) & 15, b = it >> 11;
    const float lr = fminf(lam_re[(dir * 16 + g) * 64 + n], -1e-4f), li = lam_im[(dir * 16 + g) * 64 + n];
    const float dt = __expf(log_dt[dir * 16 + g]);
    float cs, sn; cis_d((double)li * (double)dt * 64.0, cs, sn);
    const float mag = __expf(lr * dt * 64.f);
    const float ar = mag * cs, ai = mag * sn;
    float hr = 0.f, hi = 0.f;
    float2 dd[32];
#pragma unroll
    for (int cc = 0; cc < 32; ++cc) {
      const int c = dir ? 31 - cc : cc;
      dd[cc] = *(const float2*)(Dst + ((size_t)g * 512 + b * 32 + c) * 256 + dir * 128 + n * 2);
    }
#pragma unroll
    for (int cc = 0; cc < 32; ++cc) {
      const int c = dir ? 31 - cc : cc;
      const size_t row = (size_t)g * 512 + b * 32 + c;
      *(unsigned*)(U2 + row * 1280 + 1024 + dir * 128 + n * 2) = pk2(hr, hi);
      const float nr = ar * hr - ai * hi + dd[cc].x, ni = ar * hi + ai * hr + dd[cc].y;
      hr = nr; hi = ni;
    }
  }
}

__device__ __forceinline__ void set_job(GemmJob& J, const bf16_t* A, int lda, const bf16_t* Bt, int ldb, int M, int N, int K, int epi, void* c0, const void* c1, const void* c2, int ldc) {
  J.A = A; J.Bt = Bt; J.strideA = 0; J.strideB = 0; J.strideC = 0; J.lda = lda; J.ldb = ldb; J.K = K; J.nM = M / 256; J.nN = N / 256; J.nb = 1;
  J.epi = epi; J.ldc = ldc; J.c0 = c0; J.c1 = c1; J.c2 = c2; J.A1 = A; J.lda1 = lda; J.ksplit = K / 64;
}


__device__ __forceinline__ void sub_barrier(unsigned* ctr, unsigned target, int swave) {
  asm volatile("s_waitcnt vmcnt(0)" ::: "memory");
  __syncthreads();
  if (swave == 0) {
    if (TIDX(0) == 0) {
      __builtin_amdgcn_fence(__ATOMIC_RELEASE, "agent");
      asm volatile("s_waitcnt vmcnt(0)" ::: "memory");
      __hip_atomic_fetch_add(ctr, 1u, __ATOMIC_RELAXED, __HIP_MEMORY_SCOPE_AGENT);
      while (__hip_atomic_load(ctr, __ATOMIC_RELAXED, __HIP_MEMORY_SCOPE_AGENT) < target) __builtin_amdgcn_s_sleep(1);
      __builtin_amdgcn_fence(__ATOMIC_ACQUIRE, "agent");
      asm volatile("s_waitcnt vmcnt(0)" ::: "memory");
    }
  }
  __syncthreads();
}

__device__ void scan_odd_phase(int swave, const Params& p, int j, char* shm, unsigned* bar) {
  const int bidx = BIDX();
  if (bidx < 128) { scan_unit<2>(swave, p, j, bidx >> 3, (bidx >> 1) & 3, bidx & 1, shm); return; }
  const int vb = bidx - 128, nv = gridDim.x - 128;
  char* ws = WS(p);
  {
    GemmJob J0;
    set_job(J0, (const bf16_t*)(ws + OFF_A16), DM, (bf16_t*)(ws + OFF_WB) + WB_IN + (size_t)O_SU * DM, DM, TOK, 256, DM, 0, ws + OFF_PU + (size_t)O_SU * 2, nullptr, nullptr, ODD_IN);
    gemm_run(swave, J0, shm, vb, nv);
  }
  sub_barrier(bar + 64 * 18, (unsigned)((j * 5 + 1) * nv), swave);
  s5_fill(swave, p, vb, nv);
  for (int step = 0; step < 4; ++step) {
    sub_barrier(bar + 64 * 18, (unsigned)((j * 5 + step + 2) * nv), swave);
    GemmJob J; J.nb = 0;
    if (step == 0) {
      set_job(J, (const bf16_t*)(ws + OFF_OFB + OFB_U2), 1280, (const bf16_t*)(ws + OFF_S5M + S5M_PM), 1024, 512, 256, 1024, 2, ws + OFF_OFB + OFB_DST, nullptr, nullptr, 256);
      J.nb = 16; J.strideA = 512 * 1280; J.strideB = 256 * 1024; J.strideC = (size_t)512 * 256 * 4;
    } else if (step == 1) {
      s5_scan_phase(swave, p, j, vb, nv);
    } else if (step == 2) {
      set_job(J, (const bf16_t*)(ws + OFF_OFB + OFB_U2), 1280, (const bf16_t*)(ws + OFF_S5M), 1280, 512, 1024, 1280, 3, ws + OFF_PU + PU_G, nullptr, nullptr, 0);
      J.nb = 16; J.strideA = 512 * 1280; J.strideB = 1024 * 1280; J.strideC = 0;
    } else {
      set_job(J, (const bf16_t*)(ws + OFF_PU + PU_G), 256, (bf16_t*)(ws + OFF_WB) + WB_GLU, 256, TOK, 256, 256, 4, ws + OFF_A16, ws + OFF_PU + PU_G, INP(p, 23) + (size_t)j * 256, 0);
    }
    if (J.nb > 0) gemm_run(swave, J, shm, vb, nv);
  }
  if (j + 1 < 2) { __syncthreads(); s5_tables(swave, p, j + 1, vb, nv); s5_ktab(swave, p, j + 1, shm, vb, nv); }
}

__device__ void conv_phase(int swave, const Params& p, int layer, int h) {
  const int tidx = TIDX(swave);
  const int bidx = BIDX();
  const bf16_t* U = (const bf16_t*)(WS(p) + OFF_PU);
  bf16_t* ACT = (bf16_t*)(WS(p) + (h ? OFF_A16 : OFF_OFB + 33554432));
  const float* cw = INP(p, 25) + (size_t)layer * 3 * 5632;
  const float* cb = INP(p, 26) + (size_t)layer * 5632;
  const int FC0 = ffn_c0(h), FFNH = ffn_n(h), NG = FFNH / 8, ULD = 2 * FFNH;
  for (int it = bidx * 512 + tidx; it < (TOK / 16) * NG; it += gridDim.x * 512) {
    const int f8 = (it % NG) * 8, t0 = (it / NG) * 16, s0 = t0 & (SEQ - 1);
    const int fa = FC0 + f8, fv = FFN + FC0 + f8;
    float wa[3][8], wv[3][8], ba[8], bv[8];
#pragma unroll
    for (int tap = 0; tap < 3; ++tap) {
      const float4 a0 = *(const float4*)(cw + tap * 5632 + fa), a1 = *(const float4*)(cw + tap * 5632 + fa + 4);
      const float4 v0 = *(const float4*)(cw + tap * 5632 + fv), v1 = *(const float4*)(cw + tap * 5632 + fv + 4);
      wa[tap][0] = a0.x; wa[tap][1] = a0.y; wa[tap][2] = a0.z; wa[tap][3] = a0.w; wa[tap][4] = a1.x; wa[tap][5] = a1.y; wa[tap][6] = a1.z; wa[tap][7] = a1.w;
      wv[tap][0] = v0.x; wv[tap][1] = v0.y; wv[tap][2] = v0.z; wv[tap][3] = v0.w; wv[tap][4] = v1.x; wv[tap][5] = v1.y; wv[tap][6] = v1.z; wv[tap][7] = v1.w;
    }
    {
      const float4 a0 = *(const float4*)(cb + fa), a1 = *(const float4*)(cb + fa + 4), v0 = *(const float4*)(cb + fv), v1 = *(const float4*)(cb + fv + 4);
      ba[0] = a0.x; ba[1] = a0.y; ba[2] = a0.z; ba[3] = a0.w; ba[4] = a1.x; ba[5] = a1.y; ba[6] = a1.z; ba[7] = a1.w;
      bv[0] = v0.x; bv[1] = v0.y; bv[2] = v0.z; bv[3] = v0.w; bv[4] = v1.x; bv[5] = v1.y; bv[6] = v1.z; bv[7] = v1.w;
    }
    const bf16_t* base = U + (size_t)t0 * ULD + f8;
    const uint4 zero4 = make_uint4(0u, 0u, 0u, 0u);
    uint4 pa = zero4, pv = zero4;
    if (s0 > 0) { pa = ld_nt16(base - ULD); pv = ld_nt16(base - ULD + FFNH); }
    uint4 ca = ld_nt16(base), cv = ld_nt16(base + FFNH);
#pragma unroll 4
    for (int i = 0; i < 16; ++i) {
      uint4 na = zero4, nv = zero4;
      if (s0 + i + 1 < SEQ) { na = ld_nt16(base + (size_t)(i + 1) * ULD); nv = ld_nt16(base + (size_t)(i + 1) * ULD + FFNH); }
      const unsigned rp[4] = {pa.x, pa.y, pa.z, pa.w}, rc[4] = {ca.x, ca.y, ca.z, ca.w}, rn[4] = {na.x, na.y, na.z, na.w};
      const unsigned qp[4] = {pv.x, pv.y, pv.z, pv.w}, qc[4] = {cv.x, cv.y, cv.z, cv.w}, qn[4] = {nv.x, nv.y, nv.z, nv.w};
      float oa[8], ov[8];
#pragma unroll
      for (int e = 0; e < 4; ++e) {
        oa[2 * e] = ba[2 * e] + lo_bf(rp[e]) * wa[0][2 * e] + lo_bf(rc[e]) * wa[1][2 * e] + lo_bf(rn[e]) * wa[2][2 * e];
        oa[2 * e + 1] = ba[2 * e + 1] + hi_bf(rp[e]) * wa[0][2 * e + 1] + hi_bf(rc[e]) * wa[1][2 * e + 1] + hi_bf(rn[e]) * wa[2][2 * e + 1];
        ov[2 * e] = bv[2 * e] + lo_bf(qp[e]) * wv[0][2 * e] + lo_bf(qc[e]) * wv[1][2 * e] + lo_bf(qn[e]) * wv[2][2 * e];
        ov[2 * e + 1] = bv[2 * e + 1] + hi_bf(qp[e]) * wv[0][2 * e + 1] + hi_bf(qc[e]) * wv[1][2 * e + 1] + hi_bf(qn[e]) * wv[2][2 * e + 1];
      }
      uint4 o;
      o.x = pk2(siluf_(oa[0]) * ov[0], siluf_(oa[1]) * ov[1]); o.y = pk2(siluf_(oa[2]) * ov[2], siluf_(oa[3]) * ov[3]);
      o.z = pk2(siluf_(oa[4]) * ov[4], siluf_(oa[5]) * ov[5]); o.w = pk2(siluf_(oa[6]) * ov[6], siluf_(oa[7]) * ov[7]);
      *(uint4*)(ACT + (size_t)(t0 + i) * FFNH + f8) = o;
      pa = ca; pv = cv; ca = na; cv = nv;
    }
  }
}

constexpr int NPHASES = 4 * 11 + 1;

__device__ void run_phase(int swave, const Params& p, int ph, char* shm) {
  if (ph == NPHASES - 1) { final_norm(swave, OUTP(p), (const bf16_t*)(WS(p) + OFF_PU), INP(p, 3)); return; }
  const int layer = ph / 11, s = ph - layer * 11;
  const int j = layer >> 1;
  const bool odd = layer & 1;
  if (s == 0) { prep_phase(swave, p, layer, shm); return; }
  char* ws = WS(p);
  bf16_t* WB = (bf16_t*)(ws + OFF_WB);
  const bf16_t* A16 = (const bf16_t*)(ws + OFF_A16);
  GemmJob J; J.nb = 0;
  if (s == 1) { if (!odd) set_job(J, A16, DM, WB + WB_IN, DM, TOK, EVEN_INP, DM, 0, ws + OFF_PU, nullptr, nullptr, EVEN_INP);
                else set_job(J, A16, DM, WB + WB_IN, DM, TOK, 2560, DM, 0, ws + OFF_PU, nullptr, nullptr, ODD_IN); }
  else if (s == 2) { if (!odd) scan_even_phase(swave, p, j, shm); else scan_odd_phase(swave, p, j, shm, (unsigned*)(ws + OFF_BAR)); }
  else if (s == 3) { if (!odd) post_even_phase(swave, p, j); else post_odd_phase(swave, p, j); }
  else if (s == 4) set_job(J, A16, DM, WB + WB_OUT, DM, TOK, DM, DM, 0, ws + OFF_PU, nullptr, nullptr, DM);
  else if (s == 5) { float* o = OUTP(p); rmsnorm_rows_bf16(swave, layer == 0 ? INP(p, 0) : (const float*)o, (const bf16_t*)(ws + OFF_PU), o, INP(p, 2) + (size_t)layer * DM, (bf16_t*)(ws + OFF_A16)); }
  else if (s == 10) {
    set_job(J, (const bf16_t*)(ws + OFF_OFB + 33554432), 1536, WB + WB_DOWN, FFN, TOK, DM, FFN, 0, ws + OFF_PU, nullptr, nullptr, DM);
    J.A1 = (const bf16_t*)(ws + OFF_A16); J.lda1 = 1280; J.ksplit = 24;
  } else {
    const int fs = s - 6, h = fs >> 1;
    const int c0 = ffn_c0(h), nh = ffn_n(h);
    if ((fs & 1) == 0) set_job(J, A16, DM, WB + WB_UP + (size_t)2 * c0 * 1024, DM, TOK, 2 * nh, DM, 0, ws + OFF_PU, nullptr, nullptr, 2 * nh);
    else conv_phase(swave, p, layer, h);
  }
  if (J.nb > 0) gemm_run(swave, J, shm, BIDX(), gridDim.x);
}

constexpr int BAR_WORDS = 64 * 19 + 64;
__device__ __forceinline__ unsigned xcc_id() { return (unsigned)__builtin_amdgcn_s_getreg((3 << 11) | 20) & 7u; }
__device__ __forceinline__ void grid_barrier(unsigned* bar, unsigned k, unsigned info, int swave) {
  const unsigned myxcc = info & 0xffu, nmine = (info >> 8) & 0xffffu, nxcc = info >> 24;
  asm volatile("s_waitcnt vmcnt(0)" ::: "memory");
  __syncthreads();
  if (swave == 0) {
    if (TIDX(0) == 0) {
      const unsigned old = __hip_atomic_fetch_add(bar + 64 * (8 + myxcc), 1u, __ATOMIC_RELAXED, __HIP_MEMORY_SCOPE_AGENT);
      if (old + 1u == k * nmine) {
        __builtin_amdgcn_fence(__ATOMIC_RELEASE, "agent");
        asm volatile("s_waitcnt vmcnt(0)" ::: "memory");
        __hip_atomic_fetch_add(bar + 64 * 16, 1u, __ATOMIC_RELAXED, __HIP_MEMORY_SCOPE_AGENT);
      }
      while (__hip_atomic_load(bar + 64 * 16, __ATOMIC_RELAXED, __HIP_MEMORY_SCOPE_AGENT) < k * nxcc) __builtin_amdgcn_s_sleep(1);
      __builtin_amdgcn_fence(__ATOMIC_ACQUIRE, "agent");
      asm volatile("s_waitcnt vmcnt(0)" ::: "memory");
    }
  }
  __syncthreads();
}

__global__ void __launch_bounds__(512, 2) mega(Params p, int ph_lo, int ph_hi) {
  extern __shared__ __attribute__((aligned(16))) char shm[];
  cg::grid_group grid = cg::this_grid();
  const int swave = __builtin_amdgcn_readfirstlane(threadIdx.x >> 6);
  unsigned* bar = (unsigned*)(p.ws + OFF_BAR);
  unsigned info = 0;
  if (ph_hi - ph_lo > 1) {
    if (blockIdx.x == 0) for (int i = threadIdx.x; i < 19; i += 512) __hip_atomic_store(bar + 64 * i, 0u, __ATOMIC_RELAXED, __HIP_MEMORY_SCOPE_AGENT);
    grid.sync();
    const unsigned myxcc = xcc_id();
    if (threadIdx.x == 0) {
      __hip_atomic_fetch_add(bar + 64 * myxcc, 1u, __ATOMIC_RELAXED, __HIP_MEMORY_SCOPE_AGENT);
      __hip_atomic_fetch_add(bar + 64 * 17, 1u, __ATOMIC_RELAXED, __HIP_MEMORY_SCOPE_AGENT);
      while (__hip_atomic_load(bar + 64 * 17, __ATOMIC_RELAXED, __HIP_MEMORY_SCOPE_AGENT) < gridDim.x) __builtin_amdgcn_s_sleep(1);
    }
    __syncthreads();
    unsigned nxcc = 0, nmine = 1;
    for (int i = 0; i < 8; ++i) { const unsigned c = __hip_atomic_load(bar + 64 * i, __ATOMIC_RELAXED, __HIP_MEMORY_SCOPE_AGENT); nxcc += c ? 1u : 0u; if (i == (int)myxcc) nmine = c; }
    info = __builtin_amdgcn_readfirstlane(myxcc | (nmine << 8) | (nxcc << 24));
  }
  unsigned epoch = 0;
  for (int ph = ph_lo; ph < ph_hi; ++ph) {
    if (ph > ph_lo) { epoch += 1; grid_barrier(bar, epoch, info, swave); }
#if PROBE_MODE == 3
    if (ph > ph_lo) { epoch += 1; grid_barrier(bar, epoch, info, swave); }
#endif
    run_phase(swave, p, ph, shm);
  }
}

extern "C" void kernel_launch(void* const* d_in, const int* in_sizes, int n_in, void* d_out, int out_size, void* d_ws, size_t ws_size,
                              hipStream_t stream) {
  constexpr size_t kDynLds = 147456;
  static int grid_blocks = 0;
  if (!grid_blocks) {
    hipFuncSetAttribute((const void*)mega, hipFuncAttributeMaxDynamicSharedMemorySize, (int)kDynLds);
    int dev = 0, cus = 0, per_cu = 0;
    hipGetDevice(&dev);
    hipDeviceGetAttribute(&cus, hipDeviceAttributeMultiprocessorCount, dev);
    hipOccupancyMaxActiveBlocksPerMultiprocessor(&per_cu, mega, 512, kDynLds);
    if (per_cu < 1) per_cu = 1;
    grid_blocks = cus;
    if (ws_size < WS_NEEDED) fprintf(stderr, "workspace too small: %zu < %zu\n", ws_size, (size_t)WS_NEEDED);
  }
  Params p{};
  for (int i = 0; i < 28; ++i) p.in[i] = (const float*)d_in[i];
  p.out = (float*)d_out;
  p.ws = (char*)d_ws;
#if MULTI_LAUNCH
  for (int ph = 0; ph < NPHASES; ++ph) hipLaunchKernelGGL(mega, dim3(grid_blocks), dim3(512), kDynLds, stream, p, ph, ph + 1);
#else
  int lo = 0, hi = NPHASES;
  void* args[] = {&p, &lo, &hi};
  hipError_t e = hipLaunchCooperativeKernel((const void*)mega, dim3(grid_blocks), dim3(512), args, kDynLds, stream);
  if (e != hipSuccess) fprintf(stderr, "cooperative launch failed: %s (grid %d)\n", hipGetErrorString(e), grid_blocks);
#endif
}
```

```cpp
#include <hip/hip_runtime.h>
#include <hip/hip_cooperative_groups.h>
#include <cstdio>
namespace cg = cooperative_groups;

typedef unsigned short bf16_t;
typedef short bf16x8 __attribute__((ext_vector_type(8)));
typedef float f32x4 __attribute__((ext_vector_type(4)));

#ifndef MULTI_LAUNCH
#define MULTI_LAUNCH 0
#endif
#ifndef PROBE_MODE
#define PROBE_MODE 0
#endif

constexpr int TOK = 32768, SEQ = 2048, NBATCH = 16, DM = 1024;
constexpr float EPS = 1e-6f;
constexpr int EVEN_INP = 3584;
constexpr int ODD_IN = 2816;
constexpr int FFN = 2816;
__device__ __forceinline__ int ffn_c0(int h) { return h ? 1536 : 0; }
__device__ __forceinline__ int ffn_n(int h) { return h ? 1280 : 1536; }
constexpr int E_GQ = 0, E_GK = 256, E_GV = 512, E_GR = 1024, E_GLF = 1536, E_GLB = 1552, E_HQ = 1568, E_HZF = 1824, E_HZB = 2080, E_HI = 2336, E_HG = 2848;
constexpr int O_RQ = 0, O_RK = 512, O_RV = 1024, O_RG = 1792, O_SU = 2560;

constexpr size_t OFF_A16 = 0;
constexpr size_t OFF_OFB = 67108864;
constexpr size_t OFF_PU = 201326592;
constexpr size_t OFF_WB = 436207616;
constexpr size_t OFF_S5M = 463077376;
constexpr size_t OFF_MISC = 513409024;
constexpr size_t OFF_BAR = 516538368;
constexpr size_t WS_NEEDED = 516538368 + 8192;
constexpr size_t OFB_OB_EVEN = 67108864;
constexpr size_t OFB_OB_ODD = 50331648;
constexpr size_t OFB_U2 = 100663296;
constexpr size_t OFB_DST = 121634816;
constexpr size_t PU_G = 184549376;
constexpr size_t WB_IN = 0, WB_OUT = 3670016, WB_UP = 4718592, WB_DOWN = 10485760, WB_GLU = 13369344;
constexpr size_t S5M_PM = 41943040;
constexpr size_t MISC_ROPE = 2080768;

struct Params {
  const float* in[28];
  float* out;
  char* ws;
};


__device__ __forceinline__ int TIDX(int swave) {
  int t = swave * 64 + (int)__builtin_amdgcn_mbcnt_hi(~0u, __builtin_amdgcn_mbcnt_lo(~0u, 0u));
  asm volatile("" : "+v"(t)); return t; }
__device__ __forceinline__ int BIDX() { int t = blockIdx.x; asm volatile("" : "+s"(t)); return t; }
__device__ __forceinline__ size_t opaque0() { size_t z = 0; asm volatile("" : "+s"(z)); return z; }
__device__ __forceinline__ const float* INP(const Params& p, int k) { return p.in[k] + opaque0(); }
__device__ __forceinline__ char* WS(const Params& p) { return p.ws + opaque0(); }
__device__ __forceinline__ float* OUTP(const Params& p) { return p.out + opaque0(); }

typedef unsigned u32x4_t __attribute__((ext_vector_type(4)));
typedef unsigned u32x2_t __attribute__((ext_vector_type(2)));
__device__ __forceinline__ uint4 ld_nt16(const void* p) { const u32x4_t t = __builtin_nontemporal_load((const u32x4_t*)p); return make_uint4(t[0], t[1], t[2], t[3]); }
__device__ __forceinline__ uint2 ld_nt8(const void* p) { const u32x2_t t = __builtin_nontemporal_load((const u32x2_t*)p); return make_uint2(t[0], t[1]); }
__device__ __forceinline__ float4 ld_nt16f(const void* p) { const f32x4 t = __builtin_nontemporal_load((const f32x4*)p); return make_float4(t[0], t[1], t[2], t[3]); }
__device__ __forceinline__ void lds_barrier() {
  asm volatile("s_waitcnt lgkmcnt(0)" ::: "memory");
  __builtin_amdgcn_s_barrier();
  asm volatile("" ::: "memory");
}
__device__ __forceinline__ float bf2f(bf16_t v) { return __uint_as_float(((unsigned)v) << 16); }
typedef float f32x2_t __attribute__((ext_vector_type(2)));
typedef __bf16 bf16x2_t __attribute__((ext_vector_type(2)));
__device__ __forceinline__ unsigned pk2(float lo, float hi) { f32x2_t v = {lo, hi}; bf16x2_t b = __builtin_convertvector(v, bf16x2_t); return __builtin_bit_cast(unsigned, b); }
__device__ __forceinline__ bf16_t f2bf(float f) { return (bf16_t)(pk2(f, 0.f) & 0xffffu); }
__device__ __forceinline__ float lo_bf(unsigned u) { return __uint_as_float(u << 16); }
__device__ __forceinline__ float hi_bf(unsigned u) { return __uint_as_float(u & 0xffff0000u); }
__device__ __forceinline__ float sigmoidf_(float x) { return __builtin_amdgcn_rcpf(1.f + __expf(-x)); }
__device__ __forceinline__ float siluf_(float x) { return x * __builtin_amdgcn_rcpf(1.f + __expf(-x)); }
__device__ __forceinline__ float wave_sum(float v, int lane) {
#pragma unroll
  for (int o = 32; o > 0; o >>= 1) v += __int_as_float(__builtin_amdgcn_ds_bpermute((lane ^ o) << 2, __float_as_int(v)));
  return v;
}
__device__ __forceinline__ float gelu_tanh(float x) {
  float u = 0.7978845608028654f * (x + 0.044715f * x * x * x);
  float t = 1.f - 2.f * __builtin_amdgcn_rcpf(__expf(2.f * u) + 1.f);
  return 0.5f * x * (1.f + t);
}
__device__ __forceinline__ void cis_d(double ang, float& c, float& s) {
  double k = rint(ang * 0.15915494309189535);
  float r = (float)(ang - k * 6.283185307179586);
  c = __cosf(r); s = __sinf(r);
}

constexpr int HTB = 16384;
__device__ __forceinline__ int lds_byte(int r, int c) {
  int st = (r >> 4) * 2 + (c >> 5), rr = r & 15, cc = c & 31, ob = rr * 64 + cc * 2;
  return st * 1024 + (ob ^ (((ob >> 9) & 1) << 5));
}
__device__ __forceinline__ void stage_rc(int b, int& R, int& C) {
  int st = b / 1024, sb = b % 1024, swz = sb ^ (((sb >> 9) & 1) << 5);
  R = (st >> 1) * 16 + swz / 64; C = (st & 1) * 32 + (swz % 64) / 2;
}
typedef __attribute__((address_space(3))) unsigned lds_u32;

template <class Epi>
__device__ __forceinline__ void gemm_tile(int swave, const bf16_t* __restrict__ A, int lda, const bf16_t* __restrict__ A1, int lda1, int ksplit, const bf16_t* __restrict__ Bt, int ldb, int K,
                                          int brow, int bcol, char* shm, const Epi& epi) {
  const int tidx = TIDX(swave);
#define SA(b, h) (shm + ((b) * 2 + (h)) * HTB)
#define SB(b, h) (shm + (4 + (b) * 2 + (h)) * HTB)
#define STAGE(P, BASE, LD, O0, O1, br, kt) do { const bf16_t* _g = (BASE) + ((size_t)(br) * (LD) + (size_t)(kt) * 64); \
    __builtin_amdgcn_global_load_lds((const unsigned*)(_g + O0), (lds_u32*)((P) + swave * 1024), 16, 0, 0); \
    __builtin_amdgcn_global_load_lds((const unsigned*)(_g + (size_t)64 * (LD) + O0), (lds_u32*)((P) + swave * 1024 + 8192), 16, 0, 0); } while (0)
#define STAGEA(P, br, kt) do { const int _kt = (kt); const bool _s = _kt >= ksplit; const int _ld = _s ? lda1 : lda; \
    const bf16_t* _g = (_s ? A1 : A) + ((size_t)(br) * _ld + (size_t)(_s ? _kt - ksplit : _kt) * 64); const unsigned _o = _s ? offA1 : offA0; \
    __builtin_amdgcn_global_load_lds((const unsigned*)(_g + _o), (lds_u32*)((P) + swave * 1024), 16, 0, 0); \
    __builtin_amdgcn_global_load_lds((const unsigned*)(_g + (size_t)64 * _ld + _o), (lds_u32*)((P) + swave * 1024 + 8192), 16, 0, 0); } while (0)
#define LDA(dst, b, h) for (int m = 0; m < 4; ++m) for (int k = 0; k < 2; ++k) \
    dst[m][k] = *reinterpret_cast<const bf16x8*>(SA(b, h) + lds_byte(wr * 64 + m * 16 + fr, k * 32 + fq * 8))
#define LDB(dst, b, h) for (int n = 0; n < 2; ++n) for (int k = 0; k < 2; ++k) \
    dst[n][k] = *reinterpret_cast<const bf16x8*>(SB(b, h) + lds_byte(wc * 32 + n * 16 + fr, k * 32 + fq * 8))
#define MMA(ai, bj, At_, Bt_) do { __builtin_amdgcn_s_setprio(1); \
    for (int m = 0; m < 4; ++m) for (int n = 0; n < 2; ++n) for (int k = 0; k < 2; ++k) \
      acc[ai][bj][m][n] = __builtin_amdgcn_mfma_f32_16x16x32_bf16(Bt_[n][k], At_[m][k], acc[ai][bj][m][n], 0, 0, 0); \
    __builtin_amdgcn_s_setprio(0); } while (0)
#define WAIT_V(n) asm volatile("s_waitcnt vmcnt(" #n ")" ::: "memory")
#define WAIT_L(n) asm volatile("s_waitcnt lgkmcnt(" #n ")" ::: "memory")
#define BAR __builtin_amdgcn_s_barrier()
#define SCHED __builtin_amdgcn_sched_barrier(0)
  const int wid = tidx >> 6, lane = tidx & 63, wr = wid >> 2, wc = wid & 3, fr = lane & 15, fq = lane >> 4;
  f32x4 acc[2][2][4][2] = {};
  bf16x8 At[4][2], B0[2][2], B1[2][2];
  const int nt = K / 64;
  unsigned offA0, offA1, offB0;
  { int _r, _c; stage_rc(tidx * 16, _r, _c); offA0 = _r * lda + _c; offA1 = _r * lda1 + _c; offB0 = _r * ldb + _c; }
  STAGE(SB(0, 0), Bt, ldb, offB0, 0, bcol, 0); STAGEA(SA(0, 0), brow, 0);
  STAGE(SB(0, 1), Bt, ldb, offB0, 0, bcol + 128, 0); STAGEA(SA(0, 1), brow + 128, 0);
  if (wr == 1) BAR;
  WAIT_V(4); BAR;
  STAGE(SB(1, 0), Bt, ldb, offB0, 0, bcol, 1); STAGEA(SA(1, 0), brow, 1); STAGE(SB(1, 1), Bt, ldb, offB0, 0, bcol + 128, 1);
  WAIT_V(6); BAR;
  for (int t = 0; t < nt - 2; t += 2) {
    LDB(B0, 0, 0); SCHED; LDA(At, 0, 0); STAGEA(SA(1, 1), brow + 128, t + 1);
    WAIT_L(8); BAR; WAIT_L(0); MMA(0, 0, At, B0); BAR; SCHED;
    LDB(B1, 0, 1); STAGE(SB(0, 0), Bt, ldb, offB0, 0, bcol, t + 2);
    BAR; WAIT_L(0); MMA(0, 1, At, B1); BAR;
    LDA(At, 0, 1); STAGEA(SA(0, 0), brow, t + 2);
    BAR; WAIT_L(0); MMA(1, 0, At, B0); BAR; SCHED;
    STAGE(SB(0, 1), Bt, ldb, offB0, 0, bcol + 128, t + 2);
    WAIT_V(6); BAR; MMA(1, 1, At, B1); BAR;
    LDB(B0, 1, 0); SCHED; LDA(At, 1, 0); STAGEA(SA(0, 1), brow + 128, t + 2);
    WAIT_L(8); BAR; WAIT_L(0); MMA(0, 0, At, B0); BAR; SCHED;
    LDB(B1, 1, 1); STAGE(SB(1, 0), Bt, ldb, offB0, 0, bcol, t + 3);
    BAR; WAIT_L(0); MMA(0, 1, At, B1); BAR;
    LDA(At, 1, 1); STAGEA(SA(1, 0), brow, t + 3);
    BAR; WAIT_L(0); MMA(1, 0, At, B0); BAR; SCHED;
    STAGE(SB(1, 1), Bt, ldb, offB0, 0, bcol + 128, t + 3);
    WAIT_V(6); BAR; MMA(1, 1, At, B1); BAR;
  }
  { LDB(B0, 0, 0); LDA(At, 0, 0); STAGEA(SA(1, 1), brow + 128, nt - 1);
    BAR; WAIT_L(0); MMA(0, 0, At, B0); BAR;
    LDB(B1, 0, 1); BAR; WAIT_L(0); MMA(0, 1, At, B1); BAR;
    LDA(At, 0, 1); WAIT_V(4); BAR; WAIT_L(0); MMA(1, 0, At, B0); MMA(1, 1, At, B1); BAR; }
  { LDB(B0, 1, 0); LDA(At, 1, 0); WAIT_V(2); BAR; WAIT_L(0); MMA(0, 0, At, B0); BAR;
    LDB(B1, 1, 1); WAIT_V(0); BAR; WAIT_L(0); MMA(0, 1, At, B1); BAR;
    LDA(At, 1, 1); BAR; WAIT_L(0); MMA(1, 0, At, B0); MMA(1, 1, At, B1); BAR; }
  if (wr == 0) BAR;
#pragma unroll
  for (int ai = 0; ai < 2; ++ai)
#pragma unroll
    for (int m = 0; m < 4; ++m)
#pragma unroll
      for (int bj = 0; bj < 2; ++bj)
#pragma unroll
        for (int n = 0; n < 2; ++n)
          epi(brow + ai * 128 + wr * 64 + m * 16 + fr, bcol + bj * 128 + wc * 32 + n * 16 + fq * 4, acc[ai][bj][m][n]);
#undef SA
#undef SB
#undef STAGE
#undef STAGEA
#undef LDA
#undef LDB
#undef MMA
}

__device__ __forceinline__ void tile_map(int wgid, int nM, int nN, int& pm, int& pn) {
  const int nwg = nM * nN;
  { const int q = nwg / 8, r = nwg % 8, xcd = wgid % 8, off = wgid / 8; wgid = (xcd < r ? xcd * (q + 1) : r * (q + 1) + (xcd - r) * q) + off; }
  const int nig = 8 * nN, gid = wgid / nig, fm = gid * 8, gsz = (nM - fm) < 8 ? (nM - fm) : 8;
  pm = fm + ((wgid % nig) % gsz); pn = (wgid % nig) / gsz;
}

struct GemmJob {
  const bf16_t* A; const bf16_t* Bt; size_t strideA, strideB, strideC;
  int lda, ldb, K, nM, nN, nb, epi, ldc;
  void* c0; const void* c1; const void* c2;
  const bf16_t* A1; int lda1, ksplit;
};
struct EpiAny {
  int epi, ldc, g; void* c0; const void* c1; const void* c2;
  __device__ __forceinline__ void pair(int row, int col, f32x4 v0, f32x4 v1) const {
    if (epi == 0) {
      uint4 o; o.x = pk2(v0[0], v0[1]); o.y = pk2(v0[2], v0[3]); o.z = pk2(v1[0], v1[1]); o.w = pk2(v1[2], v1[3]);
      *(uint4*)((bf16_t*)c0 + (size_t)row * ldc + col) = o;
    } else { (*this)(row, col, v0); (*this)(row, col + 4, v1); }
  }
  __device__ __forceinline__ void operator()(int row, int col, f32x4 v) const {
    if (epi == 0) {
      uint2 o; o.x = pk2(v[0], v[1]); o.y = pk2(v[2], v[3]);
      *(uint2*)((bf16_t*)c0 + (size_t)row * ldc + col) = o;
    } else if (epi == 1) {
      f32x4 s = *(const f32x4*)((const float*)c1 + (size_t)row * DM + col);
      *(f32x4*)((float*)c0 + (size_t)row * DM + col) = s + v;
    } else if (epi == 2) {
      *(f32x4*)((float*)c0 + (size_t)row * ldc + col) = v;
    } else if (epi == 3) {
      size_t token = (size_t)row * 64 + (col >> 4);
      uint2 o; o.x = pk2(gelu_tanh(v[0]), gelu_tanh(v[1])); o.y = pk2(gelu_tanh(v[2]), gelu_tanh(v[3]));
      *(uint2*)((bf16_t*)c0 + token * 256 + g * 16 + (col & 15)) = o;
    } else {
      uint2 gg = *(const uint2*)((const bf16_t*)c1 + (size_t)row * 256 + col);
      f32x4 bb = *(const f32x4*)((const float*)c2 + col);
      float g0 = lo_bf(gg.x), g1 = hi_bf(gg.x), g2 = lo_bf(gg.y), g3 = hi_bf(gg.y);
      uint2 o; o.x = pk2(g0 * sigmoidf_(v[0] + bb[0]), g1 * sigmoidf_(v[1] + bb[1]));
      o.y = pk2(g2 * sigmoidf_(v[2] + bb[2]), g3 * sigmoidf_(v[3] + bb[3]));
      *(uint2*)((bf16_t*)c0 + (size_t)row * DM + 768 + col) = o;
    }
  }
};
__device__ __forceinline__ void gemm_run_tiles(int swave, const GemmJob& J, char* shm, int vb, int G) {
  const int per = J.nM * J.nN, ntile = per * J.nb;
  for (int id = vb; id < ntile; id += G) {
    int g = 0, pm, pn;
    if (J.nb == 1) tile_map(id, J.nM, J.nN, pm, pn);
    else { g = id / per; const int rem = id - g * per; pm = rem / J.nN; pn = rem - pm * J.nN; }
    EpiAny e{J.epi, J.ldc, g, (void*)((char*)J.c0 + (size_t)g * J.strideC), J.c1, J.c2};
    gemm_tile(swave, J.A + (size_t)g * J.strideA, J.lda, J.A1 + (size_t)g * J.strideA, J.lda1, J.ksplit, J.Bt + (size_t)g * J.strideB, J.ldb, J.K, pm * 256, pn * 256, shm, e);
  }
}

__device__ __forceinline__ int perm32(int rho) { const int n = rho >> 4, i = rho & 15; return 8 * (i >> 2) + 4 * n + (i & 3); }
__device__ __forceinline__ void gemm_stream(int swave, const GemmJob& J, char* shm, int vb, int G) {
  const int tidx = TIDX(swave);
  const int per = J.nM * J.nN, ntile = per * J.nb;
  if (vb >= ntile) return;
  const int lda = J.lda, lda1 = J.lda1, ksplit = J.ksplit, ldb = J.ldb, K = J.K, nt = K / 64;
#define SA(b, h) (shm + ((b) * 2 + (h)) * HTB)
#define SB(b, h) (shm + (4 + (b) * 2 + (h)) * HTB)
#define STG(P, PTR, LD, O0) do { const bf16_t* _g = (PTR); \
    __builtin_amdgcn_global_load_lds((const unsigned*)(_g + O0), (lds_u32*)((P) + swave * 1024), 16, 0, 0); \
    __builtin_amdgcn_global_load_lds((const unsigned*)(_g + (size_t)64 * (LD) + O0), (lds_u32*)((P) + swave * 1024 + 8192), 16, 0, 0); } while (0)
#define STGA(P, B0_, B1_, kt, half) do { const int _kt = (kt); const bool _s = _kt >= ksplit; const int _ld = _s ? lda1 : lda; \
    const bf16_t* _g = (_s ? (B1_) + (size_t)(_kt - ksplit) * 64 : (B0_) + (size_t)_kt * 64) + ((half) ? (size_t)128 * _ld : (size_t)0); const unsigned _o = _s ? offA1 : offA0; \
    __builtin_amdgcn_global_load_lds((const unsigned*)(_g + _o), (lds_u32*)((P) + swave * 1024), 16, 0, 0); \
    __builtin_amdgcn_global_load_lds((const unsigned*)(_g + (size_t)64 * _ld + _o), (lds_u32*)((P) + swave * 1024 + 8192), 16, 0, 0); } while (0)
#define LDA(dst, b, h) for (int m = 0; m < 4; ++m) for (int k = 0; k < 2; ++k) \
    dst[m][k] = *reinterpret_cast<const bf16x8*>(SA(b, h) + lds_byte(wr * 64 + m * 16 + fr, k * 32 + fq * 8))
#define LDB(dst, b, h) for (int n = 0; n < 2; ++n) for (int k = 0; k < 2; ++k) \
    dst[n][k] = *reinterpret_cast<const bf16x8*>(SB(b, h) + lds_byte(wc * 32 + n * 16 + fr, k * 32 + fq * 8))
#define MMA(ai, bj, At_, Bt_) do { __builtin_amdgcn_s_setprio(1); \
    for (int m = 0; m < 4; ++m) for (int n = 0; n < 2; ++n) for (int k = 0; k < 2; ++k) \
      acc[ai][bj][m][n] = __builtin_amdgcn_mfma_f32_16x16x32_bf16(Bt_[n][k], At_[m][k], acc[ai][bj][m][n], 0, 0, 0); \
    __builtin_amdgcn_s_setprio(0); } while (0)
#define WAIT_V(n) asm volatile("s_waitcnt vmcnt(" #n ")" ::: "memory")
#define WAIT_L(n) asm volatile("s_waitcnt lgkmcnt(" #n ")" ::: "memory")
#define BAR __builtin_amdgcn_s_barrier()
#define SCHED __builtin_amdgcn_sched_barrier(0)
  const int wid = tidx >> 6, lane = tidx & 63, wr = wid >> 2, wc = wid & 3, fr = lane & 15, fq = lane >> 4;
  unsigned offA0, offA1, offB0;
  { int _r, _c; stage_rc(tidx * 16, _r, _c); offA0 = _r * lda + _c; offA1 = _r * lda1 + _c; const int _rb = (_r & ~31) + perm32(_r & 31); offB0 = _rb * ldb + _c; }
  const size_t hB = (size_t)128 * ldb;
  int cg, cbrow, cbcol; const bf16_t* cA; const bf16_t* cA1; const bf16_t* cB;
  auto decode = [&](int id, int& g, int& brow, int& bcol, const bf16_t*& pA, const bf16_t*& pA1, const bf16_t*& pB) {
    int pm, pn; g = 0;
    if (J.nb == 1) tile_map(id, J.nM, J.nN, pm, pn);
    else { g = id / per; const int rem = id - g * per; pm = rem / J.nN; pn = rem - pm * J.nN; }
    brow = pm * 256; bcol = pn * 256;
    pA = J.A + (size_t)g * J.strideA + (size_t)brow * lda; pA1 = J.A1 + (size_t)g * J.strideA + (size_t)brow * lda1; pB = J.Bt + (size_t)g * J.strideB + (size_t)bcol * ldb;
  };
  int id = vb;
  decode(id, cg, cbrow, cbcol, cA, cA1, cB);
  f32x4 acc[2][2][4][2] = {};
  bf16x8 At[4][2], B0[2][2], B1[2][2];
  STG(SB(0, 0), cB, ldb, offB0); STGA(SA(0, 0), cA, cA1, 0, 0); STG(SB(0, 1), cB + hB, ldb, offB0); STGA(SA(0, 1), cA, cA1, 0, 1);
  if (wr == 1) BAR;
  WAIT_V(4); BAR;
  STG(SB(1, 0), cB + 64, ldb, offB0); STGA(SA(1, 0), cA, cA1, 1, 0); STG(SB(1, 1), cB + hB + 64, ldb, offB0);
  WAIT_V(6); BAR;
  for (;;) {
    const int nid = id + G; const bool has_next = nid < ntile;
    int ng = cg, nbrow = cbrow, nbcol = cbcol; const bf16_t* nA = cA; const bf16_t* nA1 = cA1; const bf16_t* nB = cB;
    if (has_next) decode(nid, ng, nbrow, nbcol, nA, nA1, nB);
    for (int t = 0; t < nt; t += 2) {
      const bool last = (t == nt - 2);
      const bf16_t* xA = last ? nA : cA; const bf16_t* xA1 = last ? nA1 : cA1; const int k2 = last ? 0 : t + 2;
      const bf16_t* b2 = last ? nB : cB + (size_t)(t + 2) * 64; const bf16_t* b3 = b2 + 64;
      LDB(B0, 0, 0); SCHED; LDA(At, 0, 0); STGA(SA(1, 1), cA, cA1, t + 1, 1);
      WAIT_L(8); BAR; WAIT_L(0); MMA(0, 0, At, B0); BAR; SCHED;
      LDB(B1, 0, 1); STG(SB(0, 0), b2, ldb, offB0);
      BAR; WAIT_L(0); MMA(0, 1, At, B1); BAR;
      LDA(At, 0, 1); STGA(SA(0, 0), xA, xA1, k2, 0);
      BAR; WAIT_L(0); MMA(1, 0, At, B0); BAR; SCHED;
      STG(SB(0, 1), b2 + hB, ldb, offB0);
      WAIT_V(6); BAR; MMA(1, 1, At, B1); BAR;
      LDB(B0, 1, 0); SCHED; LDA(At, 1, 0); STGA(SA(0, 1), xA, xA1, k2, 1);
      WAIT_L(8); BAR; WAIT_L(0); MMA(0, 0, At, B0); BAR; SCHED;
      LDB(B1, 1, 1); STG(SB(1, 0), b3, ldb, offB0);
      BAR; WAIT_L(0); MMA(0, 1, At, B1); BAR;
      LDA(At, 1, 1); STGA(SA(1, 0), xA, xA1, k2 + 1, 0);
      BAR; WAIT_L(0); MMA(1, 0, At, B0); BAR; SCHED;
      STG(SB(1, 1), b3 + hB, ldb, offB0);
      WAIT_V(6); BAR; MMA(1, 1, At, B1); BAR;
    }
    {
      bf16_t* C = (bf16_t*)((char*)J.c0 + (size_t)cg * J.strideC);
#pragma unroll
      for (int ai = 0; ai < 2; ++ai)
#pragma unroll
        for (int m = 0; m < 4; ++m)
#pragma unroll
          for (int bj = 0; bj < 2; ++bj) {
            const f32x4 v0 = acc[ai][bj][m][0], v1 = acc[ai][bj][m][1];
            uint4 o; o.x = pk2(v0[0], v0[1]); o.y = pk2(v0[2], v0[3]); o.z = pk2(v1[0], v1[1]); o.w = pk2(v1[2], v1[3]);
            *(uint4*)(C + (size_t)(cbrow + ai * 128 + wr * 64 + m * 16 + fr) * J.ldc + cbcol + bj * 128 + wc * 32 + fq * 8) = o;
          }
    }
    if (!has_next) break;
#pragma unroll
    for (int a_ = 0; a_ < 2; ++a_)
#pragma unroll
      for (int b_ = 0; b_ < 2; ++b_)
#pragma unroll
        for (int m = 0; m < 4; ++m)
#pragma unroll
          for (int n = 0; n < 2; ++n) acc[a_][b_][m][n] = (f32x4){0.f, 0.f, 0.f, 0.f};
    id = nid; cg = ng; cbrow = nbrow; cbcol = nbcol; cA = nA; cA1 = nA1; cB = nB;
  }
  WAIT_V(0);
  if (wr == 0) BAR;
  BAR;
#undef SA
#undef SB
#undef STG
#undef STGA
#undef LDA
#undef LDB
#undef MMA
}
__device__ __forceinline__ void gemm_run(int swave, const GemmJob& J, char* shm, int vb, int G) {
  if (J.epi == 0) gemm_stream(swave, J, shm, vb, G);
  else gemm_run_tiles(swave, J, shm, vb, G);
}

__device__ __forceinline__ int transpose_tiles(int swave, const float* __restrict__ src, int lds_, int Kc, int Nc, bf16_t* __restrict__ dst, int ldd, char* shm, int job0, int bidx, int G) {
  const int tidx = TIDX(swave);
  float* tile = (float*)shm;
  const int nkt = Kc / 64, nnt = (Nc + 63) / 64, ntile = nkt * nnt;
  const int tid = tidx;
  int t0 = (bidx - job0 % G + G) % G;
  const int kk0 = tid >> 4, n4 = (tid & 15) * 4;
  float4 v0 = make_float4(0.f, 0.f, 0.f, 0.f), v1 = v0;
  auto issue = [&](int t, float4& a, float4& b) {
    const int kt = t % nkt, ntl = t / nkt, k0 = kt * 64, n0 = ntl * 64;
    a = make_float4(0.f, 0.f, 0.f, 0.f); b = a;
    if (n0 + n4 < Nc) { a = ld_nt16f(src + (size_t)(k0 + kk0) * lds_ + n0 + n4); b = ld_nt16f(src + (size_t)(k0 + kk0 + 32) * lds_ + n0 + n4); }
  };
  if (t0 < ntile) issue(t0, v0, v1);
  for (int t = t0; t < ntile; t += G) {
    const int kt = t % nkt, ntl = t / nkt, k0 = kt * 64, n0 = ntl * 64;
    lds_barrier();
    tile[kk0 * 65 + n4 + 0] = v0.x; tile[kk0 * 65 + n4 + 1] = v0.y; tile[kk0 * 65 + n4 + 2] = v0.z; tile[kk0 * 65 + n4 + 3] = v0.w;
    tile[(kk0 + 32) * 65 + n4 + 0] = v1.x; tile[(kk0 + 32) * 65 + n4 + 1] = v1.y; tile[(kk0 + 32) * 65 + n4 + 2] = v1.z; tile[(kk0 + 32) * 65 + n4 + 3] = v1.w;
    if (t + G < ntile) issue(t + G, v0, v1);
    lds_barrier();
    const int nn = tid >> 3, k8 = (tid & 7) * 8;
    if (n0 + nn < Nc) {
      uint4 o;
      o.x = pk2(tile[(k8 + 0) * 65 + nn], tile[(k8 + 1) * 65 + nn]);
      o.y = pk2(tile[(k8 + 2) * 65 + nn], tile[(k8 + 3) * 65 + nn]);
      o.z = pk2(tile[(k8 + 4) * 65 + nn], tile[(k8 + 5) * 65 + nn]);
      o.w = pk2(tile[(k8 + 6) * 65 + nn], tile[(k8 + 7) * 65 + nn]);
      *(uint4*)(dst + (size_t)(n0 + nn) * ldd + k0 + k8) = o;
    }
  }
  __syncthreads();
  return job0 + ntile;
}

__device__ __forceinline__ void rmsnorm_rows_bf16(int swave, const float* xsrc, const bf16_t* add, float* xdst, const float* g, bf16_t* out) {
  const int tidx = TIDX(swave);
  const int bidx = BIDX();
  const int wave = tidx >> 6, lane = tidx & 63;
  float4 gg[4];
#pragma unroll
  for (int u = 0; u < 4; ++u) gg[u] = ((const float4*)g)[lane + 64 * u];
  for (int row = (bidx * 8 + wave) * 2; row < TOK; row += gridDim.x * 16) {
    const float4* xr = (const float4*)(xsrc + (size_t)row * DM);
    float4 v[8]; float s0 = 0.f, s1 = 0.f;
#pragma unroll
    for (int u = 0; u < 8; ++u) { const f32x4 t = __builtin_nontemporal_load((const f32x4*)xr + lane + 64 * u); v[u] = make_float4(t[0], t[1], t[2], t[3]); }
    if (add) {
      const uint2* ar = (const uint2*)(add + (size_t)row * DM);
      uint2 av[8];
#pragma unroll
      for (int u = 0; u < 8; ++u) av[u] = ar[lane + 64 * u];
#pragma unroll
      for (int u = 0; u < 8; ++u) { v[u].x += lo_bf(av[u].x); v[u].y += hi_bf(av[u].x); v[u].z += lo_bf(av[u].y); v[u].w += hi_bf(av[u].y); }
      float4* xw = (float4*)(xdst + (size_t)row * DM);
#pragma unroll
      for (int u = 0; u < 8; ++u) { const f32x4 t = {v[u].x, v[u].y, v[u].z, v[u].w}; __builtin_nontemporal_store(t, (f32x4*)xw + lane + 64 * u); }
    }
#pragma unroll
    for (int u = 0; u < 4; ++u) {
      s0 += v[u].x * v[u].x + v[u].y * v[u].y + v[u].z * v[u].z + v[u].w * v[u].w;
      s1 += v[u + 4].x * v[u + 4].x + v[u + 4].y * v[u + 4].y + v[u + 4].z * v[u + 4].z + v[u + 4].w * v[u + 4].w;
    }
#pragma unroll
    for (int o = 32; o > 0; o >>= 1) {
      s0 += __int_as_float(__builtin_amdgcn_ds_bpermute((lane ^ o) << 2, __float_as_int(s0)));
      s1 += __int_as_float(__builtin_amdgcn_ds_bpermute((lane ^ o) << 2, __float_as_int(s1)));
    }
    const float r0 = rsqrtf(s0 * (1.f / DM) + EPS), r1 = rsqrtf(s1 * (1.f / DM) + EPS);
#pragma unroll
    for (int u = 0; u < 8; ++u) {
      const float r = u < 4 ? r0 : r1; const float4 g4 = gg[u & 3];
      uint2 o; o.x = pk2(v[u].x * r * g4.x, v[u].y * r * g4.y); o.y = pk2(v[u].z * r * g4.z, v[u].w * r * g4.w);
      *(uint2*)(out + (size_t)row * DM + (lane + 64 * u) * 4) = o;
    }
  }
}
__device__ __forceinline__ void final_norm(int swave, float* x, const bf16_t* add, const float* g) {
  const int tidx = TIDX(swave);
  const int bidx = BIDX();
  const int wave = tidx >> 6, lane = tidx & 63;
  for (int row = bidx * 8 + wave; row < TOK; row += gridDim.x * 8) {
    float4* xr = (float4*)(x + (size_t)row * DM);
    const uint2* ar = (const uint2*)(add + (size_t)row * DM);
    float4 v[4]; float ss = 0.f;
#pragma unroll
    for (int u = 0; u < 4; ++u) {
      v[u] = ld_nt16f(xr + lane + 64 * u); const uint2 a2 = ar[lane + 64 * u];
      v[u].x += lo_bf(a2.x); v[u].y += hi_bf(a2.x); v[u].z += lo_bf(a2.y); v[u].w += hi_bf(a2.y);
      ss += v[u].x * v[u].x + v[u].y * v[u].y + v[u].z * v[u].z + v[u].w * v[u].w;
    }
    ss = wave_sum(ss, lane);
    const float r = rsqrtf(ss * (1.f / DM) + EPS);
#pragma unroll
    for (int u = 0; u < 4; ++u) {
      float4 gg = ((const float4*)g)[lane + 64 * u];
      { const f32x4 t = {v[u].x * r * gg.x, v[u].y * r * gg.y, v[u].z * r * gg.z, v[u].w * r * gg.w}; __builtin_nontemporal_store(t, (f32x4*)xr + lane + 64 * u); }
    }
  }
}

__device__ void s5_tables(int swave, const Params& p, int j, int bidx, int nblk) {
  const int tidx = TIDX(swave);
  const float* lam_re = INP(p, 14) + (size_t)j * 2 * 16 * 64;
  const float* lam_im = INP(p, 15) + (size_t)j * 2 * 16 * 64;
  const float* log_dt = INP(p, 16) + (size_t)j * 2 * 16;
  const float* b_re = INP(p, 17) + (size_t)j * 16 * 64 * 16;
  const float* b_im = INP(p, 18) + (size_t)j * 16 * 64 * 16;
  const float* c_re = INP(p, 19) + (size_t)j * 16 * 16 * 64;
  const float* c_im = INP(p, 20) + (size_t)j * 16 * 16 * 64;
  bf16_t* TRt = (bf16_t*)(WS(p) + OFF_S5M);
  bf16_t* Pm = (bf16_t*)(WS(p) + OFF_S5M + S5M_PM);
  const int gtid = bidx * 512 + tidx, gsz = nblk * 512;
  for (int it = gtid; it < 16 * 2 * 64 * 64; it += gsz) {
    const int n = it & 63, t = (it >> 6) & 63, dir = (it >> 12) & 1, g = it >> 13;
    const float lr = fminf(lam_re[(dir * 16 + g) * 64 + n], -1e-4f), li = lam_im[(dir * 16 + g) * 64 + n];
    const float dt = __expf(log_dt[dir * 16 + g]);
    const int dist = dir == 0 ? (t + 1) : (64 - t);
    float cs, sn; cis_d((double)li * (double)dt * (double)dist, cs, sn);
    const float mag = __expf(lr * dt * (float)dist);
    const float er = mag * cs, ei = mag * sn;
#pragma unroll 4
    for (int pp = 0; pp < 16; ++pp) {
      const float cr = c_re[(g * 16 + pp) * 64 + n], ci = c_im[(g * 16 + pp) * 64 + n];
      const float Er = cr * er - ci * ei, Ei = cr * ei + ci * er;
      *(unsigned*)(TRt + ((size_t)g * 1024 + t * 16 + pp) * 1280 + 1024 + dir * 128 + n * 2) = pk2(Er, -Ei);
    }
  }
  for (int it = gtid; it < 16 * 2 * 64 * 64; it += gsz) {
    const int t = it & 63, n = (it >> 6) & 63, dir = (it >> 12) & 1, g = it >> 13;
    const float lr = fminf(lam_re[(dir * 16 + g) * 64 + n], -1e-4f), li = lam_im[(dir * 16 + g) * 64 + n];
    const float dt = __expf(log_dt[dir * 16 + g]);
    float c1, s1; cis_d((double)li * (double)dt, c1, s1);
    const float m1 = __expf(lr * dt);
    const float ar = m1 * c1, ai = m1 * s1;
    const float den = lr * lr + li * li, nr = ar - 1.f;
    const float cr = (nr * lr + ai * li) / den, ci = (ai * lr - nr * li) / den;
    const int e = dir == 0 ? (63 - t) : t;
    float ce, se; cis_d((double)li * (double)dt * (double)e, ce, se);
    const float me = __expf(lr * dt * (float)e);
    const float pr = me * ce, pi = me * se;
    const float wr_ = pr * cr - pi * ci, wi_ = pr * ci + pi * cr;
    unsigned ore[8], oim[8];
#pragma unroll
    for (int pp = 0; pp < 16; pp += 2) {
      const float br0 = b_re[(g * 64 + n) * 16 + pp], bi0 = b_im[(g * 64 + n) * 16 + pp];
      const float br1 = b_re[(g * 64 + n) * 16 + pp + 1], bi1 = b_im[(g * 64 + n) * 16 + pp + 1];
      ore[pp >> 1] = pk2(wr_ * br0 - wi_ * bi0, wr_ * br1 - wi_ * bi1);
      oim[pp >> 1] = pk2(wr_ * bi0 + wi_ * br0, wr_ * bi1 + wi_ * br1);
    }
    uint4* rowre = (uint4*)(Pm + ((size_t)g * 256 + dir * 128 + n * 2 + 0) * 1024 + t * 16);
    uint4* rowim = (uint4*)(Pm + ((size_t)g * 256 + dir * 128 + n * 2 + 1) * 1024 + t * 16);
    rowre[0] = make_uint4(ore[0], ore[1], ore[2], ore[3]); rowre[1] = make_uint4(ore[4], ore[5], ore[6], ore[7]);
    rowim[0] = make_uint4(oim[0], oim[1], oim[2], oim[3]); rowim[1] = make_uint4(oim[4], oim[5], oim[6], oim[7]);
  }
}

__device__ void s5_ktab(int swave, const Params& p, int j, char* shm, int bidx, int nblk) {
  const int tidx = TIDX(swave);
  const float* lam_re = INP(p, 14) + (size_t)j * 2 * 16 * 64;
  const float* lam_im = INP(p, 15) + (size_t)j * 2 * 16 * 64;
  const float* log_dt = INP(p, 16) + (size_t)j * 2 * 16;
  const float* b_re = INP(p, 17) + (size_t)j * 16 * 64 * 16;
  const float* b_im = INP(p, 18) + (size_t)j * 16 * 64 * 16;
  const float* c_re = INP(p, 19) + (size_t)j * 16 * 16 * 64;
  const float* c_im = INP(p, 20) + (size_t)j * 16 * 16 * 64;
  const float* dsk = INP(p, 21) + (size_t)j * 256;
  float* Ktab = (float*)(WS(p) + OFF_MISC);
  float* wre = (float*)shm;
  float* wim = wre + 2 * 64 * 16;
  const int tid = tidx;
  for (int unit = bidx; unit < 16 * 127; unit += nblk) {
    const int g = unit / 127, delta = unit % 127;
    const int tau = delta >= 63 ? delta - 63 : 63 - delta;
    __syncthreads();
    for (int e = tid; e < 2 * 64 * 16; e += 512) {
      const int pp = e & 15, n = (e >> 4) & 63, dir = e >> 10;
      const float lr = fminf(lam_re[(dir * 16 + g) * 64 + n], -1e-4f), li = lam_im[(dir * 16 + g) * 64 + n];
      const float dt = __expf(log_dt[dir * 16 + g]);
      float c1, s1; cis_d((double)li * (double)dt, c1, s1);
      const float m1 = __expf(lr * dt);
      const float ar = m1 * c1, ai = m1 * s1;
      const float den = lr * lr + li * li, nr = ar - 1.f;
      const float cr = (nr * lr + ai * li) / den, ci = (ai * lr - nr * li) / den;
      float ce, se; cis_d((double)li * (double)dt * (double)tau, ce, se);
      const float me = __expf(lr * dt * (float)tau);
      const float pr = me * ce, pi = me * se;
      const float wr_ = pr * cr - pi * ci, wi_ = pr * ci + pi * cr;
      const float br = b_re[(g * 64 + n) * 16 + pp], bi = b_im[(g * 64 + n) * 16 + pp];
      wre[e] = wr_ * br - wi_ * bi; wim[e] = wr_ * bi + wi_ * br;
    }
    __syncthreads();
    if (tid < 256) {
      const int pq = tid >> 4, pp = tid & 15;
      float accv = 0.f;
      const int d0 = delta > 63 ? 0 : (delta < 63 ? 1 : 0), d1 = delta == 63 ? 1 : d0;
      for (int dir = d0; dir <= d1; ++dir)
        for (int n = 0; n < 64; ++n) {
          const float cr = c_re[(g * 16 + pq) * 64 + n], ci = c_im[(g * 16 + pq) * 64 + n];
          accv += cr * wre[(dir * 64 + n) * 16 + pp] - ci * wim[(dir * 64 + n) * 16 + pp];
        }
      if (delta == 63 && pq == pp) accv += dsk[g * 16 + pq];
      Ktab[((size_t)g * 127 + delta) * 256 + pq * 16 + pp] = accv;
    }
  }
  __syncthreads();
}

__device__ int convert_inproj(int swave, const Params& p, int layer, char* shm, int job, int bidx, int G) {
  bf16_t* WB = (bf16_t*)(WS(p) + OFF_WB);
  const int j = layer >> 1;
  if (!(layer & 1)) return transpose_tiles(swave, INP(p, 4) + (size_t)j * 1024 * 3360, 3360, 1024, 3360, WB + WB_IN, 1024, shm, job, bidx, G);
  return transpose_tiles(swave, INP(p, 11) + (size_t)j * 1024 * 2816, 2816, 1024, 2816, WB + WB_IN, 1024, shm, job, bidx, G);
}
__device__ int convert_ffn(int swave, const Params& p, int layer, char* shm, int job, int bidx, int G) {
  bf16_t* WB = (bf16_t*)(WS(p) + OFF_WB);
  const float* wup = INP(p, 24) + (size_t)layer * 1024 * 5632;
  const float* wdn = INP(p, 27) + (size_t)layer * 2816 * 1024;
  job = transpose_tiles(swave, wdn, 1024, FFN, 1024, WB + WB_DOWN, FFN, shm, job, bidx, G);
  for (int h = 0; h < 2; ++h) {
    const int c0 = ffn_c0(h), nh = ffn_n(h);
    bf16_t* up = WB + WB_UP + (size_t)2 * c0 * 1024;
    job = transpose_tiles(swave, wup + c0, 5632, 1024, nh, up, 1024, shm, job, bidx, G);
    job = transpose_tiles(swave, wup + FFN + c0, 5632, 1024, nh, up + (size_t)nh * 1024, 1024, shm, job, bidx, G);
  }
  return job;
}

__device__ void prep_phase(int swave, const Params& p, int layer, char* shm) {
  const int tidx = TIDX(swave);
  const int bidx = BIDX();
  const int j = layer >> 1;
  const bool odd = layer & 1;
  const int G = gridDim.x;
  bf16_t* WB = (bf16_t*)(WS(p) + OFF_WB);
  int job = 0;
  if (!odd) {
    if (layer == 0) job = convert_inproj(swave, p, layer, shm, job, bidx, G);
    job = transpose_tiles(swave, INP(p, 5) + (size_t)j * 1024 * 1024, 1024, 1024, 1024, WB + WB_OUT, 1024, shm, job, bidx, G);
    job = convert_ffn(swave, p, layer, shm, job, bidx, G);
  } else {
    job = convert_inproj(swave, p, layer, shm, job, bidx, G);
    job = transpose_tiles(swave, INP(p, 12) + (size_t)j * 1024 * 1024, 1024, 1024, 1024, WB + WB_OUT, 1024, shm, job, bidx, G);
    job = transpose_tiles(swave, INP(p, 22) + (size_t)j * 256 * 256, 256, 256, 256, WB + WB_GLU, 256, shm, job, bidx, G);
  }
  if (layer == 0) rmsnorm_rows_bf16(swave, INP(p, 0), nullptr, nullptr, INP(p, 1), (bf16_t*)(WS(p) + OFF_A16));
  else { float* o = OUTP(p); rmsnorm_rows_bf16(swave, o, (const bf16_t*)(WS(p) + OFF_PU), o, INP(p, 1) + (size_t)layer * DM, (bf16_t*)(WS(p) + OFF_A16)); }
  if (layer == 1) { s5_tables(swave, p, j, BIDX(), gridDim.x); s5_ktab(swave, p, j, shm, BIDX(), gridDim.x); }
  if (layer == 0) {
    float2* rope = (float2*)(WS(p) + OFF_MISC + MISC_ROPE);
    for (int it = bidx * 512 + tidx; it < SEQ * 64; it += gridDim.x * 512) {
      const int i = it & 63, pos = it >> 6;
      const double inv = (double)exp2f(-(float)i * (13.287712379549449f / 64.0f));
      float c, s; cis_d((double)pos * inv, c, s);
      rope[it] = make_float2(c, s);
    }
  }
}

template <int MODE>
__device__ void scan_unit(int swave, const Params& p, int j, int b, int h, int dir, char* shm) {
  const int tidx = TIDX(swave);
  constexpr int DK = MODE == 2 ? 128 : 64, DV = MODE == 2 ? 192 : 128, KS = DK / 64, NVT = (DV / 16) / (8 / KS);
  constexpr int QS = DK + 8, VS = 20, OS = DV + 4;
  constexpr int OFF_KT = 16 * QS * 2, OFF_KO = OFF_KT + 16 * QS * 2, OFF_VT = OFF_KO + DK * 32, OFF_DEC = OFF_VT + DV * VS * 2, BUFB = OFF_DEC + DK * 4;
  constexpr int LDP = MODE == 2 ? ODD_IN : EVEN_INP;
  constexpr int OLD = MODE == 2 ? 768 : 1024;
  char* buf0 = shm;

  bf16_t* obuf0 = (bf16_t*)(shm + 4 * BUFB);
  const bf16_t* P = (const bf16_t*)(WS(p) + OFF_PU);
  const int tid = tidx, lane = tid & 63, w = tid >> 6, r = lane & 15, q4 = lane >> 4;
  const int wk = w % KS, wv = w / KS, slab = wk * 64, vt0 = wv * NVT;
  const int hh = MODE == 1 ? 4 + h : h;
  bf16_t* O = (bf16_t*)(WS(p) + OFF_OFB + (dir ? (MODE == 2 ? OFB_OB_ODD : OFB_OB_EVEN) : 0)) + hh * DV;
  const size_t rowbase = (size_t)b * SEQ;
  const int ti = lane & 15, dp = (tid >> 4) * 2;
  float wa2r[32]; float bav0 = 0.f, bav1 = 0.f, lbv0 = 0.f, lbv1 = 0.f, lg = 0.f;
  const float2* rope = (const float2*)(WS(p) + OFF_MISC + MISC_ROPE);
  if (MODE == 0) {
    const float* wa2 = INP(p, 6) + ((size_t)(j * 2 + dir) * 16) * 256 + h * 64 + dp;
#pragma unroll
    for (int rr = 0; rr < 16; ++rr) { const float2 t2 = *(const float2*)(wa2 + rr * 256); wa2r[2 * rr] = t2.x; wa2r[2 * rr + 1] = t2.y; }
    const float2 bb = *(const float2*)(INP(p, 7) + (j * 2 + dir) * 256 + h * 64 + dp);
    bav0 = bb.x; bav1 = bb.y;
  } else if (MODE == 1) {
    if (j > 0) {
      const float2 l0 = *(const float2*)(INP(p, 9) + (dir * 2 + 0) * 256 + h * 64 + dp), l1 = *(const float2*)(INP(p, 9) + (dir * 2 + 1) * 256 + h * 64 + dp);
      lbv0 = 1.f / (1.f + __expf(l0.x - l1.x)); lbv1 = 1.f / (1.f + __expf(l0.y - l1.y));
    }
  } else {
    lg = log1pf(-exp2f((dir ? -5.5f : -5.0f) - (float)h));
  }
  const int vg = tid >> 4;
  const float ret_ein = __expf(lg * (float)(ti + 1)), ret_eti = __expf(-lg * (float)(ti + 1)), ret_eout = __expf(lg * (float)(15 - ti)), ret_dd = __expf(lg * 16.f);
  struct Raw { unsigned q, k, q2, k2; uint4 lr0, lr1; uint2 v; unsigned v30, v31, v32; float4 cs; };
  auto tokof = [&](int c, int i) { int t = c * 16 + i; return dir ? (SEQ - 1 - t) : t; };
  auto load_raw = [&](int c, Raw& R) {
    const int tok = tokof(c, ti);
    const bf16_t* row = P + (rowbase + tok) * LDP;
    if (MODE == 0) {
      R.q = *(const unsigned*)(row + E_GQ + h * 64 + dp); R.k = *(const unsigned*)(row + E_GK + h * 64 + dp);
      const uint4* lrp = (const uint4*)(row + (dir ? E_GLB : E_GLF));
      R.lr0 = lrp[0]; R.lr1 = lrp[1];
      R.v = *(const uint2*)(row + E_GV + h * 128 + vg * 4);
    } else if (MODE == 1) {
      R.q = *(const unsigned*)(row + E_HQ + h * 64 + dp); R.k = *(const unsigned*)(row + (dir ? E_HZB : E_HZF) + h * 64 + dp);
      R.v = *(const uint2*)(row + E_HI + h * 128 + vg * 4);
    } else {
      R.q = *(const unsigned*)(row + O_RQ + h * 128 + dp); R.q2 = *(const unsigned*)(row + O_RQ + h * 128 + 64 + dp);
      R.k = *(const unsigned*)(row + O_RK + h * 128 + dp); R.k2 = *(const unsigned*)(row + O_RK + h * 128 + 64 + dp);
      R.cs = *(const float4*)(rope + tok * 64 + dp);
      const unsigned* vp = (const unsigned*)(row + O_RV + h * 192 + vg * 6);
      R.v30 = vp[0]; R.v31 = vp[1]; R.v32 = vp[2];
    }
  };
  auto row_scan = [&](float x, float& total) {
    x += __int_as_float(__builtin_amdgcn_update_dpp(0, __float_as_int(x), 0x111, 0xf, 0xf, true));
    x += __int_as_float(__builtin_amdgcn_update_dpp(0, __float_as_int(x), 0x112, 0xf, 0xf, true));
    x += __int_as_float(__builtin_amdgcn_update_dpp(0, __float_as_int(x), 0x114, 0xf, 0xf, true));
    x += __int_as_float(__builtin_amdgcn_update_dpp(0, __float_as_int(x), 0x118, 0xf, 0xf, true));
    total = __int_as_float(__builtin_amdgcn_ds_bpermute((lane | 15) << 2, __float_as_int(x)));
    return x;
  };
  auto stage2 = [&](const Raw& R, char* buf, int c) {
    bf16_t* qin = (bf16_t*)buf; bf16_t* ktil = (bf16_t*)(buf + OFF_KT); bf16_t* koutT = (bf16_t*)(buf + OFF_KO);
    bf16_t* vT = (bf16_t*)(buf + OFF_VT); float* dec = (float*)(buf + OFF_DEC);
    if (MODE != 2) {
      float g0, g1;
      if (MODE == 0) {
        float z0 = bav0, z1 = bav1;
        const unsigned lw[8] = {R.lr0.x, R.lr0.y, R.lr0.z, R.lr0.w, R.lr1.x, R.lr1.y, R.lr1.z, R.lr1.w};
#pragma unroll
        for (int e = 0; e < 8; ++e) {
          const float a0 = lo_bf(lw[e]), a1 = hi_bf(lw[e]);
          z0 += a0 * wa2r[4 * e] + a1 * wa2r[4 * e + 2];
          z1 += a0 * wa2r[4 * e + 1] + a1 * wa2r[4 * e + 3];
        }
        g0 = (fminf(z0, 0.f) - __logf(1.f + __expf(-fabsf(z0)))) * (1.f / 16.f);
        g1 = (fminf(z1, 0.f) - __logf(1.f + __expf(-fabsf(z1)))) * (1.f / 16.f);
      } else {
        const float f0 = lbv0 + (1.f - lbv0) * sigmoidf_(lo_bf(R.k)), f1 = lbv1 + (1.f - lbv1) * sigmoidf_(hi_bf(R.k));
        g0 = __logf(fmaxf(f0, 1e-20f)); g1 = __logf(fmaxf(f1, 1e-20f));
      }
      float s0, s1;
      const float cum0 = row_scan(g0, s0), cum1 = row_scan(g1, s1);
      float q0, q1, k0, k1;
      if (MODE == 0) { q0 = lo_bf(R.q); q1 = hi_bf(R.q); k0 = lo_bf(R.k) * 0.125f; k1 = hi_bf(R.k) * 0.125f; }
      else { q0 = siluf_(lo_bf(R.q)); q1 = siluf_(hi_bf(R.q)); k0 = (1.f - lbv0) * sigmoidf_(-lo_bf(R.k)); k1 = (1.f - lbv1) * sigmoidf_(-hi_bf(R.k)); }
      *(unsigned*)(qin + ti * QS + dp) = pk2(q0 * __expf(cum0), q1 * __expf(cum1));
      *(unsigned*)(ktil + ti * QS + dp) = pk2(k0 * __expf(-cum0), k1 * __expf(-cum1));
      koutT[dp * 16 + ti] = f2bf(k0 * __expf(s0 - cum0));
      koutT[(dp + 1) * 16 + ti] = f2bf(k1 * __expf(s1 - cum1));
      if (ti == 0) *(float2*)(dec + dp) = make_float2(__expf(s0), __expf(s1));
      const unsigned v0 = R.v.x, v1 = R.v.y; const int c4 = vg * 4;
      vT[(c4 + 0) * VS + ti] = (bf16_t)(v0 & 0xffff); vT[(c4 + 1) * VS + ti] = (bf16_t)(v0 >> 16);
      vT[(c4 + 2) * VS + ti] = (bf16_t)(v1 & 0xffff); vT[(c4 + 3) * VS + ti] = (bf16_t)(v1 >> 16);
    } else {
      const float KSC = 0.08838834764831845f;
      const float qx0 = lo_bf(R.q), qx1 = hi_bf(R.q), qy0 = lo_bf(R.q2), qy1 = hi_bf(R.q2);
      const float kx0 = lo_bf(R.k) * KSC, kx1 = hi_bf(R.k) * KSC, ky0 = lo_bf(R.k2) * KSC, ky1 = hi_bf(R.k2) * KSC;
      const float c0 = R.cs.x, sn0 = R.cs.y, c1 = R.cs.z, sn1 = R.cs.w;
      const float qa0 = qx0 * c0 - qy0 * sn0, qb0 = qx0 * sn0 + qy0 * c0, qa1 = qx1 * c1 - qy1 * sn1, qb1 = qx1 * sn1 + qy1 * c1;
      const float ka0 = kx0 * c0 - ky0 * sn0, kb0 = kx0 * sn0 + ky0 * c0, ka1 = kx1 * c1 - ky1 * sn1, kb1 = kx1 * sn1 + ky1 * c1;
      const float ein = ret_ein, eti = ret_eti, eout = ret_eout;
      *(unsigned*)(qin + ti * QS + dp) = pk2(qa0 * ein, qa1 * ein); *(unsigned*)(qin + ti * QS + 64 + dp) = pk2(qb0 * ein, qb1 * ein);
      *(unsigned*)(ktil + ti * QS + dp) = pk2(ka0 * eti, ka1 * eti); *(unsigned*)(ktil + ti * QS + 64 + dp) = pk2(kb0 * eti, kb1 * eti);
      koutT[dp * 16 + ti] = f2bf(ka0 * eout); koutT[(dp + 1) * 16 + ti] = f2bf(ka1 * eout);
      koutT[(64 + dp) * 16 + ti] = f2bf(kb0 * eout); koutT[(65 + dp) * 16 + ti] = f2bf(kb1 * eout);
      if (ti == 0) { const float dd = ret_dd; *(float2*)(dec + dp) = make_float2(dd, dd); *(float2*)(dec + 64 + dp) = make_float2(dd, dd); }
      const int c6 = vg * 6;
      vT[(c6 + 0) * VS + ti] = (bf16_t)(R.v30 & 0xffff); vT[(c6 + 1) * VS + ti] = (bf16_t)(R.v30 >> 16);
      vT[(c6 + 2) * VS + ti] = (bf16_t)(R.v31 & 0xffff); vT[(c6 + 3) * VS + ti] = (bf16_t)(R.v31 >> 16);
      vT[(c6 + 4) * VS + ti] = (bf16_t)(R.v32 & 0xffff); vT[(c6 + 5) * VS + ti] = (bf16_t)(R.v32 >> 16);
    }
  };
  f32x4 S[4][NVT];
#pragma unroll
  for (int a = 0; a < 4; ++a)
#pragma unroll
    for (int t = 0; t < NVT; ++t) S[a][t] = (f32x4){0.f, 0.f, 0.f, 0.f};
  auto compute = [&](const char* buf, bf16_t* obuf) {
    const bf16_t* qin = (const bf16_t*)buf; const bf16_t* ktil = (const bf16_t*)(buf + OFF_KT); const bf16_t* koutT = (const bf16_t*)(buf + OFF_KO);
    const bf16_t* vT = (const bf16_t*)(buf + OFF_VT); const float* dec = (const float*)(buf + OFF_DEC);
    bf16x8 Asc = {0, 0, 0, 0, 0, 0, 0, 0};
    if (KS == 1 || wk == 0) {
      f32x4 sc = {0.f, 0.f, 0.f, 0.f};
#pragma unroll
      for (int m = 0; m < DK / 32; ++m) {
        const bf16x8 a = *(const bf16x8*)(ktil + r * QS + m * 32 + q4 * 8);
        const bf16x8 bb = *(const bf16x8*)(qin + r * QS + m * 32 + q4 * 8);
        sc = __builtin_amdgcn_mfma_f32_16x16x32_bf16(a, bb, sc, 0, 0, 0);
      }
      {
        const unsigned p01 = pk2(q4 * 4 + 0 > r ? 0.f : sc[0], q4 * 4 + 1 > r ? 0.f : sc[1]);
        const unsigned p23 = pk2(q4 * 4 + 2 > r ? 0.f : sc[2], q4 * 4 + 3 > r ? 0.f : sc[3]);
        Asc[0] = (short)(p01 & 0xffff); Asc[1] = (short)(p01 >> 16); Asc[2] = (short)(p23 & 0xffff); Asc[3] = (short)(p23 >> 16);
      }
    }
    bf16x8 Bv[NVT];
#pragma unroll
    for (int t = 0; t < NVT; ++t) {
      const uint2 vv = *(const uint2*)(vT + ((vt0 + t) * 16 + r) * VS + q4 * 4);
      Bv[t] = (bf16x8){(short)(vv.x & 0xffff), (short)(vv.x >> 16), (short)(vv.y & 0xffff), (short)(vv.y >> 16), 0, 0, 0, 0};
    }
    bf16x8 Aq[2];
#pragma unroll
    for (int m = 0; m < 2; ++m) {
      const uint2 lo = *(const uint2*)(qin + r * QS + slab + (2 * m) * 16 + q4 * 4);
      const uint2 hi = *(const uint2*)(qin + r * QS + slab + (2 * m + 1) * 16 + q4 * 4);
      Aq[m] = (bf16x8){(short)(lo.x & 0xffff), (short)(lo.x >> 16), (short)(lo.y & 0xffff), (short)(lo.y >> 16),
                       (short)(hi.x & 0xffff), (short)(hi.x >> 16), (short)(hi.y & 0xffff), (short)(hi.y >> 16)};
    }
    f32x4 o[NVT];
#pragma unroll
    for (int t = 0; t < NVT; ++t) {
      o[t] = (f32x4){0.f, 0.f, 0.f, 0.f};
      if (KS == 1 || wk == 0) o[t] = __builtin_amdgcn_mfma_f32_16x16x32_bf16(Asc, Bv[t], o[t], 0, 0, 0);
    }
#pragma unroll
    for (int m = 0; m < 2; ++m)
#pragma unroll
      for (int t = 0; t < NVT; ++t) {
        const f32x4 s0 = S[2 * m][t], s1 = S[2 * m + 1][t];
        union { unsigned u[4]; bf16x8 v; } cv;
        cv.u[0] = pk2(s0[0], s0[1]); cv.u[1] = pk2(s0[2], s0[3]); cv.u[2] = pk2(s1[0], s1[1]); cv.u[3] = pk2(s1[2], s1[3]);
        o[t] = __builtin_amdgcn_mfma_f32_16x16x32_bf16(Aq[m], cv.v, o[t], 0, 0, 0);
      }
#pragma unroll
    for (int t = 0; t < NVT; ++t)
#pragma unroll
      for (int jj = 0; jj < 4; ++jj) obuf[(wk * 16 + q4 * 4 + jj) * OS + (vt0 + t) * 16 + r] = f2bf(o[t][jj]);
#pragma unroll
    for (int kt = 0; kt < 4; ++kt) {
      const uint2 kk = *(const uint2*)(koutT + (slab + kt * 16 + r) * 16 + q4 * 4);
      const bf16x8 Ak = {(short)(kk.x & 0xffff), (short)(kk.x >> 16), (short)(kk.y & 0xffff), (short)(kk.y >> 16), 0, 0, 0, 0};
      const f32x4 dc = *(const f32x4*)(dec + slab + kt * 16 + q4 * 4);
#pragma unroll
      for (int t = 0; t < NVT; ++t) S[kt][t] = __builtin_amdgcn_mfma_f32_16x16x32_bf16(Ak, Bv[t], S[kt][t] * dc, 0, 0, 0);
    }
  };
  auto ostore = [&](int c, const bf16_t* obuf) {
    for (int idx = tid; idx < 16 * DV / 4; idx += 512) {
      const int i = idx / (DV / 4), cc = (idx % (DV / 4)) * 4;
      uint2 o = *(const uint2*)(obuf + i * OS + cc);
      if (KS == 2) {
        const uint2 o2 = *(const uint2*)(obuf + (16 + i) * OS + cc);
        o.x = pk2(lo_bf(o.x) + lo_bf(o2.x), hi_bf(o.x) + hi_bf(o2.x)); o.y = pk2(lo_bf(o.y) + lo_bf(o2.y), hi_bf(o.y) + hi_bf(o2.y));
      }
      *(uint2*)(O + (rowbase + tokof(c, i)) * OLD + cc) = o;
    }
  };
  constexpr int NCH = SEQ / 16;
  auto touch = [&](Raw& R) {
    if (MODE == 0) {
      asm volatile("" :: "v"(R.q), "v"(R.k), "v"(R.v.x), "v"(R.v.y), "v"(R.lr0.x), "v"(R.lr0.y), "v"(R.lr0.z), "v"(R.lr0.w), "v"(R.lr1.x), "v"(R.lr1.y), "v"(R.lr1.z), "v"(R.lr1.w) : "memory");
    } else if (MODE == 1) {
      asm volatile("" :: "v"(R.q), "v"(R.k), "v"(R.v.x), "v"(R.v.y) : "memory");
    } else {
      asm volatile("" :: "v"(R.q), "v"(R.k), "v"(R.q2), "v"(R.k2), "v"(R.cs.x), "v"(R.cs.y), "v"(R.cs.z), "v"(R.cs.w), "v"(R.v30), "v"(R.v31), "v"(R.v32) : "memory");
    }
  };
  constexpr int NIT = NCH / 2, OB1 = KS * 16 * OS;
  auto bufp = [&](int stage, int sub) { return buf0 + (stage * 2 + sub) * BUFB; };
  auto obp = [&](int stage, int sub) { return obuf0 + (stage * 2 + sub) * OB1; };
  Raw a0, a1, b0, b1;
  __syncthreads();
  load_raw(0, a0); load_raw(1, a1);
  stage2(a0, bufp(0, 0), 0); stage2(a1, bufp(0, 1), 1);
  load_raw(2, a0); load_raw(3, a1);
  lds_barrier();
  auto body = [&](int it, Raw& c0, Raw& c1, Raw& n0, Raw& n1) {
    touch(c0); touch(c1);
    __builtin_amdgcn_sched_barrier(0);
    const int cA = 2 * it + 4 < NCH ? 2 * it + 4 : NCH - 2;
    load_raw(cA, n0); load_raw(cA + 1, n1);
    if (it > 0) { ostore(2 * it - 2, obp((it - 1) & 1, 0)); ostore(2 * it - 1, obp((it - 1) & 1, 1)); }
    stage2(c0, bufp((it + 1) & 1, 0), 0); stage2(c1, bufp((it + 1) & 1, 1), 0);
    compute(bufp(it & 1, 0), obp(it & 1, 0)); compute(bufp(it & 1, 1), obp(it & 1, 1));
    lds_barrier();
  };
  for (int it = 0; it < NIT; it += 2) { body(it, a0, a1, b0, b1); body(it + 1, b0, b1, a0, a1); }
  ostore(NCH - 2, obp((NIT - 1) & 1, 0)); ostore(NCH - 1, obp((NIT - 1) & 1, 1));
  __syncthreads();
}

__device__ void scan_even_phase(int swave, const Params& p, int j, char* shm) {
  const int bidx = BIDX();
  for (int unit = bidx; unit < 256; unit += gridDim.x) {
    const int dir = unit & 1, hh = (unit >> 1) & 7, b = unit >> 4;
    if (hh < 4) scan_unit<0>(swave, p, j, b, hh, dir, shm); else scan_unit<1>(swave, p, j, b, hh - 4, dir, shm);
  }
}

__device__ void s5_fill(int swave, const Params& p, int vb, int nvb) {
  const int tidx = TIDX(swave);
  const bf16_t* P = (const bf16_t*)(WS(p) + OFF_PU);
  bf16_t* U2 = (bf16_t*)(WS(p) + OFF_OFB + OFB_U2);
  bf16_t* TRt = (bf16_t*)(WS(p) + OFF_S5M);
  const float* Ktab = (const float*)(WS(p) + OFF_MISC);
  const int gtid = vb * 512 + tidx, gsz = nvb * 512;
  for (int it = gtid; it < TOK * 16; it += gsz) {
    const int g = it & 15, token = it >> 4;
    const uint4* s = (const uint4*)(P + (size_t)token * ODD_IN + O_SU + g * 16);
    uint4* d = (uint4*)(U2 + ((size_t)g * 512 + (token >> 6)) * 1280 + (token & 63) * 16);
    d[0] = s[0]; d[1] = s[1];
  }
  for (int it = gtid; it < 16 * 1024 * 128; it += gsz) {
    const int half = it & 1, jj = (it >> 1) & 63, pp = (it >> 7) & 15, t = (it >> 11) & 63, g = it >> 17;
    const float4* s = (const float4*)(Ktab + ((size_t)g * 127 + (t - jj + 63)) * 256 + pp * 16 + half * 8);
    const float4 a = s[0], bq = s[1];
    uint4 o; o.x = pk2(a.x, a.y); o.y = pk2(a.z, a.w); o.z = pk2(bq.x, bq.y); o.w = pk2(bq.z, bq.w);
    *(uint4*)(TRt + ((size_t)g * 1024 + t * 16 + pp) * 1280 + jj * 16 + half * 8) = o;
  }
}

__device__ __forceinline__ float row16_allsum(float x) {
  x += __int_as_float(__builtin_amdgcn_update_dpp(0, __float_as_int(x), 0x128, 0xf, 0xf, true));
  x += __int_as_float(__builtin_amdgcn_update_dpp(0, __float_as_int(x), 0x124, 0xf, 0xf, true));
  x += __int_as_float(__builtin_amdgcn_update_dpp(0, __float_as_int(x), 0x122, 0xf, 0xf, true));
  x += __int_as_float(__builtin_amdgcn_update_dpp(0, __float_as_int(x), 0x121, 0xf, 0xf, true));
  return x;
}
__device__ void post_even_phase(int swave, const Params& p, int j) {
  const int tidx = TIDX(swave);
  const int bidx = BIDX();
  const bf16_t* P = (const bf16_t*)(WS(p) + OFF_PU);
  const bf16_t* OF = (const bf16_t*)(WS(p) + OFF_OFB);
  const bf16_t* OB = (const bf16_t*)(WS(p) + OFF_OFB + OFB_OB_EVEN);
  bf16_t* Y = (bf16_t*)(WS(p) + OFF_A16);
  const float* gla_g = INP(p, 8) + (size_t)j * 512;
  const float* hgrn_g = INP(p, 10) + (size_t)j * 512;
  const int l16 = tidx & 15;
  for (int it = bidx * 32 + (tidx >> 4); it < TOK * 8; it += gridDim.x * 32) {
    const int hh = it & 7, token = it >> 3;
    const size_t oidx = (size_t)token * 1024 + hh * 128 + l16 * 8;
    const uint4 a = ld_nt16(OF + oidx), bq = ld_nt16(OB + oidx);
    const int gcol = (hh < 4 ? E_GR + hh * 128 : E_HG + (hh - 4) * 128) + l16 * 8;
    const uint4 gt = ld_nt16(P + (size_t)token * EVEN_INP + gcol);
    const float* gn = (hh < 4 ? gla_g + hh * 128 : hgrn_g + (hh - 4) * 128) + l16 * 8;
    const float4 gn0 = *(const float4*)gn, gn1 = *(const float4*)(gn + 4);
    const unsigned av[4] = {a.x, a.y, a.z, a.w}, bv[4] = {bq.x, bq.y, bq.z, bq.w}, gv[4] = {gt.x, gt.y, gt.z, gt.w};
    const float gnv[8] = {gn0.x, gn0.y, gn0.z, gn0.w, gn1.x, gn1.y, gn1.z, gn1.w};
    float o[8]; float ss = 0.f;
#pragma unroll
    for (int e = 0; e < 4; ++e) { o[2 * e] = lo_bf(av[e]) + lo_bf(bv[e]); o[2 * e + 1] = hi_bf(av[e]) + hi_bf(bv[e]); ss += o[2 * e] * o[2 * e] + o[2 * e + 1] * o[2 * e + 1]; }
    ss = row16_allsum(ss);
    const float rs = rsqrtf(ss * (1.f / 128.f) + EPS);
    unsigned ov[4];
#pragma unroll
    for (int e = 0; e < 4; ++e)
      ov[e] = pk2(o[2 * e] * rs * gnv[2 * e] * siluf_(lo_bf(gv[e])), o[2 * e + 1] * rs * gnv[2 * e + 1] * siluf_(hi_bf(gv[e])));
    *(uint4*)(Y + oidx) = make_uint4(ov[0], ov[1], ov[2], ov[3]);
  }
}
__device__ void post_odd_phase(int swave, const Params& p, int j) {
  const int tidx = TIDX(swave);
  const int bidx = BIDX();
  const bf16_t* P = (const bf16_t*)(WS(p) + OFF_PU);
  const bf16_t* OF = (const bf16_t*)(WS(p) + OFF_OFB);
  const bf16_t* OB = (const bf16_t*)(WS(p) + OFF_OFB + OFB_OB_ODD);
  bf16_t* Y = (bf16_t*)(WS(p) + OFF_A16);
  const float* gn = INP(p, 13) + (size_t)j * 768;
  const int l16 = tidx & 15;
  for (int it = bidx * 32 + (tidx >> 4); it < TOK * 4; it += gridDim.x * 32) {
    const int h = it & 3, token = it >> 2;
    float o[12]; float sm = 0.f;
#pragma unroll
    for (int e = 0; e < 3; ++e) {
      const size_t oidx = (size_t)token * 768 + h * 192 + e * 64 + l16 * 4;
      const uint2 a = ld_nt8(OF + oidx), bq = ld_nt8(OB + oidx);
      o[4 * e] = lo_bf(a.x) + lo_bf(bq.x); o[4 * e + 1] = hi_bf(a.x) + hi_bf(bq.x); o[4 * e + 2] = lo_bf(a.y) + lo_bf(bq.y); o[4 * e + 3] = hi_bf(a.y) + hi_bf(bq.y);
      sm += o[4 * e] + o[4 * e + 1] + o[4 * e + 2] + o[4 * e + 3];
    }
    const float mu = row16_allsum(sm) * (1.f / 192.f);
    float vs = 0.f;
#pragma unroll
    for (int e = 0; e < 12; ++e) { o[e] -= mu; vs += o[e] * o[e]; }
    const float rs = rsqrtf(row16_allsum(vs) * (1.f / 192.f) + EPS);
#pragma unroll
    for (int e = 0; e < 3; ++e) {
      const int c = h * 192 + e * 64 + l16 * 4;
      const uint2 gt = ld_nt8(P + (size_t)token * ODD_IN + O_RG + c);
      const float4 g4 = *(const float4*)(gn + c);
      uint2 ov;
      ov.x = pk2(o[4 * e] * rs * g4.x * siluf_(lo_bf(gt.x)), o[4 * e + 1] * rs * g4.y * siluf_(hi_bf(gt.x)));
      ov.y = pk2(o[4 * e + 2] * rs * g4.z * siluf_(lo_bf(gt.y)), o[4 * e + 3] * rs * g4.w * siluf_(hi_bf(gt.y)));
      *(uint2*)(Y + (size_t)token * DM + c) = ov;
    }
  }
}

__device__ void s5_scan_phase(int swave, const Params& p, int j, int vb, int nv) {
  const int tidx = TIDX(swave);
  const float* lam_re = INP(p, 14) + (size_t)j * 2 * 16 * 64;
  const float* lam_im = INP(p, 15) + (size_t)j * 2 * 16 * 64;
  const float* log_dt = INP(p, 16) + (size_t)j * 2 * 16;
  const float* Dst = (const float*)(WS(p) + OFF_OFB + OFB_DST);
  bf16_t* U2 = (bf16_t*)(WS(p) + OFF_OFB + OFB_U2);
  for (int it = vb * 512 + tidx; it < NBATCH * 16 * 2 * 64; it += nv * 512) {
    const int n = it & 63, dir = (it >> 6) & 1, g = (it >> 7) & 15, b = it >> 11;
    const float lr = fminf(lam_re[(dir * 16 + g) * 64 + n], -1e-4f), li = lam_im[(dir * 16 + g) * 64 + n];
    const float dt = __expf(log_dt[dir * 16 + g]);
    float cs, sn; cis_d((double)li * (double)dt * 64.0, cs, sn);
    const float mag = __expf(lr * dt * 64.f);
    const float ar = mag * cs, ai = mag * sn;
    float hr = 0.f, hi = 0.f;
    float2 dd[32];
#pragma unroll
    for (int cc = 0; cc < 32; ++cc) {
      const int c = dir ? 31 - cc : cc;
      dd[cc] = *(const float2*)(Dst + ((size_t)g * 512 + b * 32 + c) * 256 + dir * 128 + n * 2);
    }
#pragma unroll
    for (int cc = 0; cc < 32; ++cc) {
      const int c = dir ? 31 - cc : cc;
      const size_t row = (size_t)g * 512 + b * 32 + c;
      *(unsigned*)(U2 + row * 1280 + 1024 + dir * 128 + n * 2) = pk2(hr, hi);
      const float nr = ar * hr - ai * hi + dd[cc].x, ni = ar * hi + ai * hr + dd[cc].y;
      hr = nr; hi = ni;
    }
  }
}

__device__ __forceinline__ void set_job(GemmJob& J, const bf16_t* A, int lda, const bf16_t* Bt, int ldb, int M, int N, int K, int epi, void* c0, const void* c1, const void* c2, int ldc) {
  J.A = A; J.Bt = Bt; J.strideA = 0; J.strideB = 0; J.strideC = 0; J.lda = lda; J.ldb = ldb; J.K = K; J.nM = M / 256; J.nN = N / 256; J.nb = 1;
  J.epi = epi; J.ldc = ldc; J.c0 = c0; J.c1 = c1; J.c2 = c2; J.A1 = A; J.lda1 = lda; J.ksplit = K / 64;
}


__device__ __forceinline__ void sub_barrier(unsigned* ctr, unsigned target, int swave) {
  asm volatile("s_waitcnt vmcnt(0)" ::: "memory");
  __syncthreads();
  if (swave == 0) {
    if (TIDX(0) == 0) {
      __builtin_amdgcn_fence(__ATOMIC_RELEASE, "agent");
      asm volatile("s_waitcnt vmcnt(0)" ::: "memory");
      __hip_atomic_fetch_add(ctr, 1u, __ATOMIC_RELAXED, __HIP_MEMORY_SCOPE_AGENT);
      while (__hip_atomic_load(ctr, __ATOMIC_RELAXED, __HIP_MEMORY_SCOPE_AGENT) < target) __builtin_amdgcn_s_sleep(1);
      __builtin_amdgcn_fence(__ATOMIC_ACQUIRE, "agent");
      asm volatile("s_waitcnt vmcnt(0)" ::: "memory");
    }
  }
  __syncthreads();
}

__device__ void scan_odd_phase(int swave, const Params& p, int j, char* shm, unsigned* bar) {
  const int bidx = BIDX();
  if (bidx < 128) { scan_unit<2>(swave, p, j, bidx >> 3, (bidx >> 1) & 3, bidx & 1, shm); return; }
  const int vb = bidx - 128, nv = gridDim.x - 128;
  char* ws = WS(p);
  {
    GemmJob J0;
    set_job(J0, (const bf16_t*)(ws + OFF_A16), DM, (bf16_t*)(ws + OFF_WB) + WB_IN + (size_t)O_SU * DM, DM, TOK, 256, DM, 0, ws + OFF_PU + (size_t)O_SU * 2, nullptr, nullptr, ODD_IN);
    gemm_run(swave, J0, shm, vb, nv);
  }
  sub_barrier(bar + 64 * 18, (unsigned)((j * 5 + 1) * nv), swave);
  s5_fill(swave, p, vb, nv);
  for (int step = 0; step < 4; ++step) {
    sub_barrier(bar + 64 * 18, (unsigned)((j * 5 + step + 2) * nv), swave);
    GemmJob J; J.nb = 0;
    if (step == 0) {
      set_job(J, (const bf16_t*)(ws + OFF_OFB + OFB_U2), 1280, (const bf16_t*)(ws + OFF_S5M + S5M_PM), 1024, 512, 256, 1024, 2, ws + OFF_OFB + OFB_DST, nullptr, nullptr, 256);
      J.nb = 16; J.strideA = 512 * 1280; J.strideB = 256 * 1024; J.strideC = (size_t)512 * 256 * 4;
    } else if (step == 1) {
      s5_scan_phase(swave, p, j, vb, nv);
    } else if (step == 2) {
      set_job(J, (const bf16_t*)(ws + OFF_OFB + OFB_U2), 1280, (const bf16_t*)(ws + OFF_S5M), 1280, 512, 1024, 1280, 3, ws + OFF_PU + PU_G, nullptr, nullptr, 0);
      J.nb = 16; J.strideA = 512 * 1280; J.strideB = 1024 * 1280; J.strideC = 0;
    } else {
      set_job(J, (const bf16_t*)(ws + OFF_PU + PU_G), 256, (bf16_t*)(ws + OFF_WB) + WB_GLU, 256, TOK, 256, 256, 4, ws + OFF_A16, ws + OFF_PU + PU_G, INP(p, 23) + (size_t)j * 256, 0);
    }
    if (J.nb > 0) gemm_run(swave, J, shm, vb, nv);
  }
  if (j + 1 < 2) { __syncthreads(); s5_tables(swave, p, j + 1, vb, nv); s5_ktab(swave, p, j + 1, shm, vb, nv); }
  { __syncthreads(); int job = convert_ffn(swave, p, 2 * j + 1, shm, 0, vb, nv); if (2 * j + 2 < 4) convert_inproj(swave, p, 2 * j + 2, shm, job, vb, nv); }
}

__device__ void conv_phase(int swave, const Params& p, int layer, int h) {
  const int tidx = TIDX(swave);
  const int bidx = BIDX();
  const bf16_t* U = (const bf16_t*)(WS(p) + OFF_PU);
  bf16_t* ACT = (bf16_t*)(WS(p) + (h ? OFF_A16 : OFF_OFB + 33554432));
  const float* cw = INP(p, 25) + (size_t)layer * 3 * 5632;
  const float* cb = INP(p, 26) + (size_t)layer * 5632;
  const int FC0 = ffn_c0(h), FFNH = ffn_n(h), NG = FFNH / 8, ULD = 2 * FFNH;
  for (int it = bidx * 512 + tidx; it < (TOK / 16) * NG; it += gridDim.x * 512) {
    const int f8 = (it % NG) * 8, t0 = (it / NG) * 16, s0 = t0 & (SEQ - 1);
    const int fa = FC0 + f8, fv = FFN + FC0 + f8;
    float wa[3][8], wv[3][8], ba[8], bv[8];
#pragma unroll
    for (int tap = 0; tap < 3; ++tap) {
      const float4 a0 = *(const float4*)(cw + tap * 5632 + fa), a1 = *(const float4*)(cw + tap * 5632 + fa + 4);
      const float4 v0 = *(const float4*)(cw + tap * 5632 + fv), v1 = *(const float4*)(cw + tap * 5632 + fv + 4);
      wa[tap][0] = a0.x; wa[tap][1] = a0.y; wa[tap][2] = a0.z; wa[tap][3] = a0.w; wa[tap][4] = a1.x; wa[tap][5] = a1.y; wa[tap][6] = a1.z; wa[tap][7] = a1.w;
      wv[tap][0] = v0.x; wv[tap][1] = v0.y; wv[tap][2] = v0.z; wv[tap][3] = v0.w; wv[tap][4] = v1.x; wv[tap][5] = v1.y; wv[tap][6] = v1.z; wv[tap][7] = v1.w;
    }
    {
      const float4 a0 = *(const float4*)(cb + fa), a1 = *(const float4*)(cb + fa + 4), v0 = *(const float4*)(cb + fv), v1 = *(const float4*)(cb + fv + 4);
      ba[0] = a0.x; ba[1] = a0.y; ba[2] = a0.z; ba[3] = a0.w; ba[4] = a1.x; ba[5] = a1.y; ba[6] = a1.z; ba[7] = a1.w;
      bv[0] = v0.x; bv[1] = v0.y; bv[2] = v0.z; bv[3] = v0.w; bv[4] = v1.x; bv[5] = v1.y; bv[6] = v1.z; bv[7] = v1.w;
    }
    const bf16_t* base = U + (size_t)t0 * ULD + f8;
    const uint4 zero4 = make_uint4(0u, 0u, 0u, 0u);
    uint4 pa = zero4, pv = zero4;
    if (s0 > 0) { pa = ld_nt16(base - ULD); pv = ld_nt16(base - ULD + FFNH); }
    uint4 ca = ld_nt16(base), cv = ld_nt16(base + FFNH);
#pragma unroll 4
    for (int i = 0; i < 16; ++i) {
      uint4 na = zero4, nv = zero4;
      if (s0 + i + 1 < SEQ) { na = ld_nt16(base + (size_t)(i + 1) * ULD); nv = ld_nt16(base + (size_t)(i + 1) * ULD + FFNH); }
      const unsigned rp[4] = {pa.x, pa.y, pa.z, pa.w}, rc[4] = {ca.x, ca.y, ca.z, ca.w}, rn[4] = {na.x, na.y, na.z, na.w};
      const unsigned qp[4] = {pv.x, pv.y, pv.z, pv.w}, qc[4] = {cv.x, cv.y, cv.z, cv.w}, qn[4] = {nv.x, nv.y, nv.z, nv.w};
      float oa[8], ov[8];
#pragma unroll
      for (int e = 0; e < 4; ++e) {
        oa[2 * e] = ba[2 * e] + lo_bf(rp[e]) * wa[0][2 * e] + lo_bf(rc[e]) * wa[1][2 * e] + lo_bf(rn[e]) * wa[2][2 * e];
        oa[2 * e + 1] = ba[2 * e + 1] + hi_bf(rp[e]) * wa[0][2 * e + 1] + hi_bf(rc[e]) * wa[1][2 * e + 1] + hi_bf(rn[e]) * wa[2][2 * e + 1];
        ov[2 * e] = bv[2 * e] + lo_bf(qp[e]) * wv[0][2 * e] + lo_bf(qc[e]) * wv[1][2 * e] + lo_bf(qn[e]) * wv[2][2 * e];
        ov[2 * e + 1] = bv[2 * e + 1] + hi_bf(qp[e]) * wv[0][2 * e + 1] + hi_bf(qc[e]) * wv[1][2 * e + 1] + hi_bf(qn[e]) * wv[2][2 * e + 1];
      }
      uint4 o;
      o.x = pk2(siluf_(oa[0]) * ov[0], siluf_(oa[1]) * ov[1]); o.y = pk2(siluf_(oa[2]) * ov[2], siluf_(oa[3]) * ov[3]);
      o.z = pk2(siluf_(oa[4]) * ov[4], siluf_(oa[5]) * ov[5]); o.w = pk2(siluf_(oa[6]) * ov[6], siluf_(oa[7]) * ov[7]);
      *(uint4*)(ACT + (size_t)(t0 + i) * FFNH + f8) = o;
      pa = ca; pv = cv; ca = na; cv = nv;
    }
  }
}

constexpr int NPHASES = 4 * 11 + 1;

__device__ void run_phase(int swave, const Params& p, int ph, char* shm) {
  if (ph == NPHASES - 1) { final_norm(swave, OUTP(p), (const bf16_t*)(WS(p) + OFF_PU), INP(p, 3)); return; }
  const int layer = ph / 11, s = ph - layer * 11;
  const int j = layer >> 1;
  const bool odd = layer & 1;
  if (s == 0) { prep_phase(swave, p, layer, shm); return; }
  char* ws = WS(p);
  bf16_t* WB = (bf16_t*)(ws + OFF_WB);
  const bf16_t* A16 = (const bf16_t*)(ws + OFF_A16);
  GemmJob J; J.nb = 0;
  if (s == 1) { if (!odd) set_job(J, A16, DM, WB + WB_IN, DM, TOK, EVEN_INP, DM, 0, ws + OFF_PU, nullptr, nullptr, EVEN_INP);
                else set_job(J, A16, DM, WB + WB_IN, DM, TOK, 2560, DM, 0, ws + OFF_PU, nullptr, nullptr, ODD_IN); }
  else if (s == 2) { if (!odd) scan_even_phase(swave, p, j, shm); else scan_odd_phase(swave, p, j, shm, (unsigned*)(ws + OFF_BAR)); }
  else if (s == 3) { if (!odd) post_even_phase(swave, p, j); else post_odd_phase(swave, p, j); }
  else if (s == 4) set_job(J, A16, DM, WB + WB_OUT, DM, TOK, DM, DM, 0, ws + OFF_PU, nullptr, nullptr, DM);
  else if (s == 5) { float* o = OUTP(p); rmsnorm_rows_bf16(swave, layer == 0 ? INP(p, 0) : (const float*)o, (const bf16_t*)(ws + OFF_PU), o, INP(p, 2) + (size_t)layer * DM, (bf16_t*)(ws + OFF_A16)); }
  else if (s == 10) {
    set_job(J, (const bf16_t*)(ws + OFF_OFB + 33554432), 1536, WB + WB_DOWN, FFN, TOK, DM, FFN, 0, ws + OFF_PU, nullptr, nullptr, DM);
    J.A1 = (const bf16_t*)(ws + OFF_A16); J.lda1 = 1280; J.ksplit = 24;
  } else {
    const int fs = s - 6, h = fs >> 1;
    const int c0 = ffn_c0(h), nh = ffn_n(h);
    if ((fs & 1) == 0) set_job(J, A16, DM, WB + WB_UP + (size_t)2 * c0 * 1024, DM, TOK, 2 * nh, DM, 0, ws + OFF_PU, nullptr, nullptr, 2 * nh);
    else conv_phase(swave, p, layer, h);
  }
  if (J.nb > 0) gemm_run(swave, J, shm, BIDX(), gridDim.x);
}

constexpr int BAR_WORDS = 64 * 19 + 64;
__device__ __forceinline__ unsigned xcc_id() { return (unsigned)__builtin_amdgcn_s_getreg((3 << 11) | 20) & 7u; }
__device__ __forceinline__ void grid_barrier(unsigned* bar, unsigned k, unsigned info, int swave) {
  const unsigned myxcc = info & 0xffu, nmine = (info >> 8) & 0xffffu, nxcc = info >> 24;
  asm volatile("s_waitcnt vmcnt(0)" ::: "memory");
  __syncthreads();
  if (swave == 0) {
    if (TIDX(0) == 0) {
      const unsigned old = __hip_atomic_fetch_add(bar + 64 * (8 + myxcc), 1u, __ATOMIC_RELAXED, __HIP_MEMORY_SCOPE_AGENT);
      if (old + 1u == k * nmine) {
        __builtin_amdgcn_fence(__ATOMIC_RELEASE, "agent");
        asm volatile("s_waitcnt vmcnt(0)" ::: "memory");
        __hip_atomic_fetch_add(bar + 64 * 16, 1u, __ATOMIC_RELAXED, __HIP_MEMORY_SCOPE_AGENT);
      }
      while (__hip_atomic_load(bar + 64 * 16, __ATOMIC_RELAXED, __HIP_MEMORY_SCOPE_AGENT) < k * nxcc) __builtin_amdgcn_s_sleep(1);
      __builtin_amdgcn_fence(__ATOMIC_ACQUIRE, "agent");
      asm volatile("s_waitcnt vmcnt(0)" ::: "memory");
    }
  }
  __syncthreads();
}

__global__ void __launch_bounds__(512, 2) mega(Params p, int ph_lo, int ph_hi) {
  extern __shared__ __attribute__((aligned(16))) char shm[];
  cg::grid_group grid = cg::this_grid();
  const int swave = __builtin_amdgcn_readfirstlane(threadIdx.x >> 6);
  unsigned* bar = (unsigned*)(p.ws + OFF_BAR);
  unsigned info = 0;
  if (ph_hi - ph_lo > 1) {
    if (blockIdx.x == 0) for (int i = threadIdx.x; i < 19; i += 512) __hip_atomic_store(bar + 64 * i, 0u, __ATOMIC_RELAXED, __HIP_MEMORY_SCOPE_AGENT);
    grid.sync();
    const unsigned myxcc = xcc_id();
    if (threadIdx.x == 0) {
      __hip_atomic_fetch_add(bar + 64 * myxcc, 1u, __ATOMIC_RELAXED, __HIP_MEMORY_SCOPE_AGENT);
      __hip_atomic_fetch_add(bar + 64 * 17, 1u, __ATOMIC_RELAXED, __HIP_MEMORY_SCOPE_AGENT);
      while (__hip_atomic_load(bar + 64 * 17, __ATOMIC_RELAXED, __HIP_MEMORY_SCOPE_AGENT) < gridDim.x) __builtin_amdgcn_s_sleep(1);
    }
    __syncthreads();
    unsigned nxcc = 0, nmine = 1;
    for (int i = 0; i < 8; ++i) { const unsigned c = __hip_atomic_load(bar + 64 * i, __ATOMIC_RELAXED, __HIP_MEMORY_SCOPE_AGENT); nxcc += c ? 1u : 0u; if (i == (int)myxcc) nmine = c; }
    info = __builtin_amdgcn_readfirstlane(myxcc | (nmine << 8) | (nxcc << 24));
  }
  unsigned epoch = 0;
  for (int ph = ph_lo; ph < ph_hi; ++ph) {
    if (ph > ph_lo) { epoch += 1; grid_barrier(bar, epoch, info, swave); }
#if PROBE_MODE == 3
    if (ph > ph_lo) { epoch += 1; grid_barrier(bar, epoch, info, swave); }
#endif
    run_phase(swave, p, ph, shm);
  }
}

extern "C" void kernel_launch(void* const* d_in, const int* in_sizes, int n_in, void* d_out, int out_size, void* d_ws, size_t ws_size,
                              hipStream_t stream) {
  constexpr size_t kDynLds = 147456;
  static int grid_blocks = 0;
  if (!grid_blocks) {
    hipFuncSetAttribute((const void*)mega, hipFuncAttributeMaxDynamicSharedMemorySize, (int)kDynLds);
    int dev = 0, cus = 0, per_cu = 0;
    hipGetDevice(&dev);
    hipDeviceGetAttribute(&cus, hipDeviceAttributeMultiprocessorCount, dev);
    hipOccupancyMaxActiveBlocksPerMultiprocessor(&per_cu, mega, 512, kDynLds);
    if (per_cu < 1) per_cu = 1;
    grid_blocks = cus;
    if (ws_size < WS_NEEDED) fprintf(stderr, "workspace too small: %zu < %zu\n", ws_size, (size_t)WS_NEEDED);
  }
  Params p{};
  for (int i = 0; i < 28; ++i) p.in[i] = (const float*)d_in[i];
  p.out = (float*)d_out;
  p.ws = (char*)d_ws;
#if MULTI_LAUNCH
  for (int ph = 0; ph < NPHASES; ++ph) hipLaunchKernelGGL(mega, dim3(grid_blocks), dim3(512), kDynLds, stream, p, ph, ph + 1);
#else
  int lo = 0, hi = NPHASES;
  void* args[] = {&p, &lo, &hi};
  hipError_t e = hipLaunchCooperativeKernel((const void*)mega, dim3(grid_blocks), dim3(512), args, kDynLds, stream);
  if (e != hipSuccess) fprintf(stderr, "cooperative launch failed: %s (grid %d)\n", hipGetErrorString(e), grid_blocks);
#endif
}
```
